# Optimizing an MI355X kernel written in HIP

```python
import math
import jax
import jax.numpy as jnp
from jax import lax
import numpy as np

D_MODEL = 2048
BATCH = 8
SEQ = 2048
DEPTH = 2

N_MIXERS = 2
N_ATTN_LAYERS = (DEPTH + 1) // 2
N_RET_LAYERS = DEPTH // 2

GRID_W = 64

NA_HEADS = 16
NA_HEAD_DIM = D_MODEL // NA_HEADS
NA_MAX_KH = 8
NA_KW = 16

RET_HEADS = 8
RET_QK_DIM = D_MODEL // RET_HEADS
RET_V_DIM = 2 * RET_QK_DIM
RET_QK_WIDTH = RET_HEADS * RET_QK_DIM
RET_V_WIDTH = RET_HEADS * RET_V_DIM
RET_CHUNK = 128
ROPE_BASE = 10000.0

N_GROUPS = 4
EXPERTS_PER_GROUP = 8
TOP_K = 2
EXPERT_FF = D_MODEL // 4

DEEPNORM_ALPHA = (2 * DEPTH) ** 0.25
DEEPNORM_BETA = (8 * DEPTH) ** -0.25
LN_EPS = 1e-5
GN_EPS = 1e-6

kernel_name = "hybrid_natten_retention_hmoe_deepnorm"


def layer_norm(x, gain, bias):
    xf = x.astype(jnp.float32)
    mu = jnp.mean(xf, axis=-1, keepdims=True)
    var = jnp.mean(jnp.square(xf - mu), axis=-1, keepdims=True)
    y = (xf - mu) * lax.rsqrt(var + LN_EPS)
    return (y * gain.astype(jnp.float32) + bias.astype(jnp.float32)).astype(x.dtype)


def neighbourhood_attention(x, w_in, w_out, rpb):
    B, S, D = x.shape
    rows = S // GRID_W
    kh = min(NA_MAX_KH, rows)
    qkv = x @ w_in
    q, k, v = jnp.split(qkv, 3, axis=-1)
    grid = lambda t: t.reshape(B, rows, GRID_W, NA_HEADS, NA_HEAD_DIM)
    q = grid(q) * (NA_HEAD_DIM ** -0.5)
    k = grid(k)
    v = grid(v)
    cols = jnp.arange(GRID_W)
    col_start = jnp.clip(cols - NA_KW // 2, 0, GRID_W - NA_KW)
    col_in_win = (cols[None, :] >= col_start[:, None]) & (cols[None, :] < col_start[:, None] + NA_KW)
    dc = jnp.clip(cols[None, :] - cols[:, None], -(NA_KW - 1), NA_KW - 1) + NA_KW - 1
    rpb_c = jnp.transpose(rpb[:, :, dc], (0, 2, 1, 3))

    def row_block(r):
        rs = jnp.clip(r - kh // 2, 0, rows - kh)
        k_blk = lax.dynamic_slice_in_dim(k, rs, kh, axis=1)
        v_blk = lax.dynamic_slice_in_dim(v, rs, kh, axis=1)
        q_row = lax.dynamic_index_in_dim(q, r, axis=1, keepdims=False)
        dr = rs + jnp.arange(kh) - r + NA_MAX_KH - 1
        bias = jnp.take(rpb_c, dr, axis=2)
        s = jnp.einsum('bqhd,brkhd->bhqrk', q_row, k_blk).astype(jnp.float32)
        s = s + bias.astype(jnp.float32)[None]
        s = jnp.where(col_in_win[None, None, :, None, :], s, -jnp.inf)
        p = jax.nn.softmax(s.reshape(B, NA_HEADS, GRID_W, kh * GRID_W), axis=-1)
        p = p.reshape(B, NA_HEADS, GRID_W, kh, GRID_W).astype(v.dtype)
        return jnp.einsum('bhqrk,brkhd->bqhd', p, v_blk)

    out = lax.map(row_block, jnp.arange(rows))
    out = jnp.transpose(out, (1, 0, 2, 3, 4)).reshape(B, S, D)
    return out @ w_out


def rotary(t, positions):
    half = t.shape[-1] // 2
    freqs = ROPE_BASE ** (-jnp.arange(half, dtype=jnp.float32) / half)
    ang = positions.astype(jnp.float32)[:, None] * freqs[None, :]
    cos = jnp.cos(ang)[None, :, None, :]
    sin = jnp.sin(ang)[None, :, None, :]
    t1 = t[..., :half].astype(jnp.float32)
    t2 = t[..., half:].astype(jnp.float32)
    return jnp.concatenate([t1 * cos - t2 * sin, t1 * sin + t2 * cos], axis=-1).astype(t.dtype)


def chunk_retention(q, k, v, log_gamma, strict):
    B, H, S, dk = q.shape
    dv = v.shape[-1]
    C = RET_CHUNK
    n_chunks = S // C
    chunks = lambda t: jnp.transpose(t.reshape(B, H, n_chunks, C, t.shape[-1]), (2, 0, 1, 3, 4)).astype(jnp.float32)
    qc, kc, vc = chunks(q), chunks(k), chunks(v)
    lg = log_gamma.astype(jnp.float32)
    idx = jnp.arange(C, dtype=jnp.float32)
    diff = idx[:, None] - idx[None, :]
    allowed = (diff > 0) if strict else (diff >= 0)
    decay_mask = jnp.where(allowed[None], jnp.exp(lg[:, None, None] * jnp.maximum(diff, 0.0)[None]), 0.0)
    q_decay = jnp.exp(lg[:, None] * (idx[None, :] + 1.0))
    k_decay = jnp.exp(lg[:, None] * (C - 1.0 - idx[None, :]))
    chunk_decay = jnp.exp(lg * C)

    def step(state, inp):
        qi, ki, vi = inp
        inner = jnp.einsum('bhid,bhjd->bhij', qi, ki) * decay_mask[None]
        inner_out = jnp.einsum('bhij,bhjv->bhiv', inner, vi)
        cross = jnp.einsum('bhid,bhdv->bhiv', qi, state) * q_decay[None, :, :, None]
        new_state = state * chunk_decay[None, :, None, None] + jnp.einsum(
            'bhjd,bhjv->bhdv', ki * k_decay[None, :, :, None], vi)
        return new_state, inner_out + cross

    state0 = jnp.zeros((B, H, dk, dv), jnp.float32)
    _, out = lax.scan(step, state0, (qc, kc, vc))
    return jnp.transpose(out, (1, 2, 0, 3, 4)).reshape(B, H, S, dv)


def retention_mixer(x, w_in, w_out, decay_fwd, decay_bwd):
    B, S, D = x.shape
    proj = x @ w_in
    q, k, v, g = jnp.split(proj, [RET_QK_WIDTH, 2 * RET_QK_WIDTH, 2 * RET_QK_WIDTH + RET_V_WIDTH], axis=-1)
    pos = jnp.arange(S)
    q = rotary(q.reshape(B, S, RET_HEADS, RET_QK_DIM), pos)
    k = rotary(k.reshape(B, S, RET_HEADS, RET_QK_DIM), pos) * (RET_QK_DIM ** -0.5)
    v = v.reshape(B, S, RET_HEADS, RET_V_DIM)
    q, k, v = (jnp.transpose(t, (0, 2, 1, 3)) for t in (q, k, v))
    lg_f = jnp.log1p(-jnp.exp(decay_fwd.astype(jnp.float32)))
    lg_b = jnp.log1p(-jnp.exp(decay_bwd.astype(jnp.float32)))
    y_fwd = chunk_retention(q, k, v, lg_f, strict=False)
    flip = lambda t: jnp.flip(t, axis=2)
    y_bwd = flip(chunk_retention(flip(q), flip(k), flip(v), lg_b, strict=True))
    y = y_fwd + y_bwd
    y = y * lax.rsqrt(jnp.mean(jnp.square(y), axis=-1, keepdims=True) + GN_EPS)
    y = jnp.transpose(y, (0, 2, 1, 3)).reshape(B, S, RET_V_WIDTH).astype(x.dtype)
    return (jax.nn.silu(g) * y) @ w_out


def hierarchical_moe(x, w_group_router, b_group_router, w_expert_router, b_expert_router, w_gate, w_up, w_down):
    B, S, D = x.shape
    xt = x.reshape(B * S, D)
    n_tok = xt.shape[0]
    group_logits = (xt @ w_group_router).astype(jnp.float32) + b_group_router.astype(jnp.float32)
    group_probs = jax.nn.softmax(group_logits, axis=-1)
    g_sel = jnp.argmax(group_logits, axis=-1)
    w_grp = jnp.take_along_axis(group_probs, g_sel[:, None], axis=-1)
    exp_logits = (xt @ w_expert_router.reshape(D, N_GROUPS * EXPERTS_PER_GROUP)).astype(jnp.float32)
    exp_logits = exp_logits.reshape(n_tok, N_GROUPS, EXPERTS_PER_GROUP) + b_expert_router.astype(jnp.float32)
    sel_logits = jnp.take_along_axis(exp_logits, g_sel[:, None, None], axis=1)[:, 0]
    top_vals, top_idx = lax.top_k(sel_logits, TOP_K)
    top_w = jax.nn.softmax(top_vals, axis=-1) * w_grp
    within = jnp.sum(jax.nn.one_hot(top_idx, EXPERTS_PER_GROUP, dtype=jnp.float32) * top_w[..., None], axis=1)
    out = jnp.zeros_like(xt)
    for grp in range(N_GROUPS):
        comb = jnp.where((g_sel == grp)[:, None], within, 0.0).astype(x.dtype)
        h = jax.nn.silu(jnp.einsum('nd,edf->nef', xt, w_gate[grp])) * jnp.einsum('nd,edf->nef', xt, w_up[grp])
        out = out + jnp.einsum('nef,efd->nd', h * comb[:, :, None], w_down[grp])
    return out.reshape(B, S, D)


def _normal(key, shape, scale):
    return jax.random.normal(key, shape, jnp.float32) * scale


def setup_inputs(seed: int = 0) -> dict:
    key = jax.random.key(seed)
    ks = jax.random.split(key, 24)
    D = D_MODEL
    x = jax.random.normal(ks[0], (BATCH, SEQ, D), jnp.float32)
    attn_w_in = jnp.concatenate([
        _normal(ks[1], (N_ATTN_LAYERS, D, 2 * D), D ** -0.5),
        _normal(ks[2], (N_ATTN_LAYERS, D, D), DEEPNORM_BETA * D ** -0.5)], axis=-1)
    attn_w_out = _normal(ks[3], (N_ATTN_LAYERS, D, D), DEEPNORM_BETA * D ** -0.5)
    attn_rpb = _normal(ks[4], (N_ATTN_LAYERS, NA_HEADS, 2 * NA_MAX_KH - 1, 2 * NA_KW - 1), 0.1)
    ret_w_in = jnp.concatenate([
        _normal(ks[5], (N_RET_LAYERS, D, 2 * RET_QK_WIDTH), D ** -0.5),
        _normal(ks[6], (N_RET_LAYERS, D, RET_V_WIDTH), DEEPNORM_BETA * D ** -0.5),
        _normal(ks[7], (N_RET_LAYERS, D, RET_V_WIDTH), D ** -0.5)], axis=-1)
    ret_w_out = _normal(ks[8], (N_RET_LAYERS, RET_V_WIDTH, D), DEEPNORM_BETA * RET_V_WIDTH ** -0.5)
    base = -math.log(2.0) * (5.0 + jnp.arange(RET_HEADS, dtype=jnp.float32))
    ret_decay_fwd = base[None] + _normal(ks[9], (N_RET_LAYERS, RET_HEADS), 0.1)
    ret_decay_bwd = base[None] + _normal(ks[10], (N_RET_LAYERS, RET_HEADS), 0.1)
    moe_w_group_router = _normal(ks[11], (DEPTH, D, N_GROUPS), D ** -0.5)
    moe_b_group_router = _normal(ks[12], (DEPTH, N_GROUPS), 0.01)
    moe_w_expert_router = _normal(ks[13], (DEPTH, D, N_GROUPS, EXPERTS_PER_GROUP), D ** -0.5)
    moe_b_expert_router = _normal(ks[14], (DEPTH, N_GROUPS, EXPERTS_PER_GROUP), 0.01)
    moe_w_gate = _normal(ks[15], (DEPTH, N_GROUPS, EXPERTS_PER_GROUP, D, EXPERT_FF), D ** -0.5)
    moe_w_up = _normal(ks[16], (DEPTH, N_GROUPS, EXPERTS_PER_GROUP, D, EXPERT_FF), D ** -0.5)
    moe_w_down = _normal(ks[17], (DEPTH, N_GROUPS, EXPERTS_PER_GROUP, EXPERT_FF, D), DEEPNORM_BETA * EXPERT_FF ** -0.5)
    ln_gain = 1.0 + _normal(ks[18], (DEPTH, 2, D), 0.02)
    ln_bias = _normal(ks[19], (DEPTH, 2, D), 0.02)
    return {"x": x, "attn_w_in": attn_w_in, "attn_w_out": attn_w_out, "attn_rpb": attn_rpb,
            "ret_w_in": ret_w_in, "ret_w_out": ret_w_out, "ret_decay_fwd": ret_decay_fwd,
            "ret_decay_bwd": ret_decay_bwd, "moe_w_group_router": moe_w_group_router,
            "moe_b_group_router": moe_b_group_router, "moe_w_expert_router": moe_w_expert_router,
            "moe_b_expert_router": moe_b_expert_router, "moe_w_gate": moe_w_gate, "moe_w_up": moe_w_up,
            "moe_w_down": moe_w_down, "ln_gain": ln_gain, "ln_bias": ln_bias}


def reference(x, attn_w_in, attn_w_out, attn_rpb, ret_w_in, ret_w_out, ret_decay_fwd, ret_decay_bwd,
              moe_w_group_router, moe_b_group_router, moe_w_expert_router, moe_b_expert_router,
              moe_w_gate, moe_w_up, moe_w_down, ln_gain, ln_bias):
    for i in range(DEPTH):
        j = i // N_MIXERS
        if i % N_MIXERS == 0:
            mix = neighbourhood_attention(x, attn_w_in[j], attn_w_out[j], attn_rpb[j])
        else:
            mix = retention_mixer(x, ret_w_in[j], ret_w_out[j], ret_decay_fwd[j], ret_decay_bwd[j])
        x = layer_norm(DEEPNORM_ALPHA * x + mix, ln_gain[i, 0], ln_bias[i, 0])
        ffn = hierarchical_moe(x, moe_w_group_router[i], moe_b_group_router[i], moe_w_expert_router[i],
                               moe_b_expert_router[i], moe_w_gate[i], moe_w_up[i], moe_w_down[i])
        x = layer_norm(DEEPNORM_ALPHA * x + ffn, ln_gain[i, 1], ln_bias[i, 1])
    return x
```

```cpp
#include <hip/hip_runtime.h>
#include <cstdio>
namespace nv {
constexpr int D = 2048, S = 2048, GW = 64, ROWS = 32, NH = 16, DH = 128, KH = 8, KW = 16;
constexpr int RH = 8, RQK = 256, RV = 512, RQKW = 2048, RVW = 4096, RPROJ = 12288;
constexpr int NG = 4, NE = 8, FF = 512;
constexpr float ALPHA = 1.41421356237309515f;
constexpr float LN_EPS = 1e-5f, GN_EPS = 1e-6f;

__global__ __launch_bounds__(256) void gemm(const float* __restrict__ A, long sam, long sak, long bsA, const float* __restrict__ B, long sbk, long sbn, long bsB,
                                            float* __restrict__ C, long ldc, long bsC, int K) {
    __shared__ float As[16][65], Bs[16][65];
    A += (long)blockIdx.z * bsA; B += (long)blockIdx.z * bsB; C += (long)blockIdx.z * bsC;
    const int tid = threadIdx.x, tx = tid & 15, ty = tid >> 4;
    const long m0 = (long)blockIdx.y * 64, n0 = (long)blockIdx.x * 64;
    float acc[4][4];
#pragma unroll
    for (int i = 0; i < 4; ++i)
#pragma unroll
        for (int j = 0; j < 4; ++j) acc[i][j] = 0.f;
    for (int k0 = 0; k0 < K; k0 += 16) {
#pragma unroll
        for (int i = 0; i < 4; ++i) {
            const int idx = tid + i * 256;
            { const int r = idx >> 4, kk = idx & 15; As[kk][r] = A[(m0 + r) * sam + (long)(k0 + kk) * sak]; }
            if (sbn == 1) { const int kk = idx >> 6, c = idx & 63; Bs[kk][c] = B[(long)(k0 + kk) * sbk + (n0 + c) * sbn]; }
            else { const int c = idx >> 4, kk = idx & 15; Bs[kk][c] = B[(long)(k0 + kk) * sbk + (n0 + c) * sbn]; }
        }
        __syncthreads();
#pragma unroll
        for (int kk = 0; kk < 16; ++kk) {
            float a[4], b[4];
#pragma unroll
            for (int i = 0; i < 4; ++i) { a[i] = As[kk][ty * 4 + i]; b[i] = Bs[kk][tx * 4 + i]; }
#pragma unroll
            for (int i = 0; i < 4; ++i)
#pragma unroll
                for (int j = 0; j < 4; ++j) acc[i][j] = fmaf(a[i], b[j], acc[i][j]);
        }
        __syncthreads();
    }
#pragma unroll
    for (int i = 0; i < 4; ++i)
#pragma unroll
        for (int j = 0; j < 4; ++j) C[(m0 + ty * 4 + i) * ldc + n0 + tx * 4 + j] = acc[i][j];
}
__device__ __forceinline__ float wsum(float v) {
#pragma unroll
    for (int o = 32; o >= 1; o >>= 1) v += __shfl_xor(v, o);
    return v;
}
__device__ __forceinline__ float wmax(float v) {
#pragma unroll
    for (int o = 32; o >= 1; o >>= 1) v = fmaxf(v, __shfl_xor(v, o));
    return v;
}
__global__ __launch_bounds__(256) void natten(const float* __restrict__ qkv, const float* __restrict__ rpb, float* __restrict__ out) {
    __shared__ float ps[4][128];
    __shared__ float qs[4][128];
    const int w = threadIdx.x >> 6, lane = threadIdx.x & 63;
    const int t = blockIdx.x >> 2, h = (blockIdx.x & 3) * 4 + w;
    const int r = t / GW, c = t % GW;
    int rs = r - KH / 2; rs = rs < 0 ? 0 : (rs > ROWS - KH ? ROWS - KH : rs);
    int cs = c - KW / 2; cs = cs < 0 ? 0 : (cs > GW - KW ? GW - KW : cs);
    const float* q = qkv + (long)t * 6144 + h * DH;
    qs[w][lane] = q[lane]; qs[w][lane + 64] = q[lane + 64];
    __syncthreads();
    float sc[2];
#pragma unroll
    for (int u = 0; u < 2; ++u) {
        const int key = lane + 64 * u, i = key >> 4, j = key & 15;
        const int kt = (rs + i) * GW + cs + j;
        const float* k = qkv + (long)kt * 6144 + 2048 + h * DH;
        float s = 0.f;
        for (int d = 0; d < DH; ++d) s = fmaf(qs[w][d], k[d], s);
        const int dr = rs + i - r + KH - 1;
        int dc = cs + j - c; dc = dc < -(KW - 1) ? -(KW - 1) : (dc > KW - 1 ? KW - 1 : dc); dc += KW - 1;
        sc[u] = s * 0.08838834764831845f + rpb[(h * 15 + dr) * 31 + dc];
    }
    const float mx = wmax(fmaxf(sc[0], sc[1]));
    const float e0 = expf(sc[0] - mx), e1 = expf(sc[1] - mx);
    const float den = wsum(e0 + e1);
    ps[w][lane] = e0 / den; ps[w][lane + 64] = e1 / den;
    __syncthreads();
    float o0 = 0.f, o1 = 0.f;
    for (int key = 0; key < 128; ++key) {
        const int i = key >> 4, j = key & 15; const int kt = (rs + i) * GW + cs + j;
        const float* v = qkv + (long)kt * 6144 + 4096 + h * DH;
        const float p = ps[w][key];
        o0 = fmaf(p, v[lane], o0); o1 = fmaf(p, v[lane + 64], o1);
    }
    out[(long)t * D + h * DH + lane] = o0; out[(long)t * D + h * DH + lane + 64] = o1;
}
__global__ __launch_bounds__(256) void ln_res(const float* __restrict__ xin, const float* __restrict__ mix, const float* __restrict__ gain, const float* __restrict__ bias, float* __restrict__ out) {
    __shared__ float red[8];
    const long row = blockIdx.x; const int tid = threadIdx.x;
    float v[8]; float s = 0.f;
#pragma unroll
    for (int i = 0; i < 8; ++i) { const int c = tid + i * 256; v[i] = ALPHA * xin[row * D + c] + mix[row * D + c]; s += v[i]; }
    s = wsum(s); if ((tid & 63) == 0) red[tid >> 6] = s; __syncthreads();
    const float mean = (red[0] + red[1] + red[2] + red[3]) * (1.f / D);
    float q = 0.f;
#pragma unroll
    for (int i = 0; i < 8; ++i) { const float d = v[i] - mean; q += d * d; }
    q = wsum(q); if ((tid & 63) == 0) red[4 + (tid >> 6)] = q; __syncthreads();
    const float rstd = rsqrtf((red[4] + red[5] + red[6] + red[7]) * (1.f / D) + LN_EPS);
#pragma unroll
    for (int i = 0; i < 8; ++i) { const int c = tid + i * 256; out[row * D + c] = (v[i] - mean) * rstd * gain[c] + bias[c]; }
}
__global__ __launch_bounds__(512) void moe_ln(const float* __restrict__ x, const float* __restrict__ wgr, const float* __restrict__ bgr, const float* __restrict__ wer, const float* __restrict__ ber,
                                              const float* __restrict__ wgate, const float* __restrict__ wup, const float* __restrict__ wdown,
                                              const float* __restrict__ gain, const float* __restrict__ bias, float* __restrict__ out) {
    __shared__ float xs[D]; __shared__ float logit[40]; __shared__ float hb[FF]; __shared__ float red[16]; __shared__ int sel[4]; __shared__ float selw[2];
    const long row = blockIdx.x; const int tid = threadIdx.x, w = tid >> 6, lane = tid & 63;
    for (int c = tid; c < D; c += 512) xs[c] = x[row * D + c];
    __syncthreads();
    for (int n = w; n < 36; n += 8) {
        float s = 0.f;
        if (n < 4) { for (int k = lane; k < D; k += 64) s = fmaf(xs[k], wgr[k * 4 + n], s); }
        else { for (int k = lane; k < D; k += 64) s = fmaf(xs[k], wer[k * 32 + (n - 4)], s); }
        s = wsum(s);
        if (lane == 0) logit[n] = s + (n < 4 ? bgr[n] : ber[n - 4]);
    }
    __syncthreads();
    if (tid == 0) {
        int g = 0; float gm = logit[0];
        for (int i = 1; i < 4; ++i) if (logit[i] > gm) { gm = logit[i]; g = i; }
        float den = 0.f; for (int i = 0; i < 4; ++i) den += expf(logit[i] - gm);
        const float wg = 1.f / den;
        int e1 = 0; float v1 = logit[4 + g * 8];
        for (int i = 1; i < 8; ++i) if (logit[4 + g * 8 + i] > v1) { v1 = logit[4 + g * 8 + i]; e1 = i; }
        int e2 = -1; float v2 = 0.f;
        for (int i = 0; i < 8; ++i) if (i != e1 && (e2 < 0 || logit[4 + g * 8 + i] > v2)) { v2 = logit[4 + g * 8 + i]; e2 = i; }
        const float a = 1.f / (1.f + expf(v2 - v1));
        sel[0] = g * 8 + e1; sel[1] = g * 8 + e2; selw[0] = a * wg; selw[1] = (1.f - a) * wg;
    }
    __syncthreads();
    float o[4] = {0.f, 0.f, 0.f, 0.f};
    for (int s = 0; s < 2; ++s) {
        const long E = sel[s]; const float cw = selw[s];
        const float* Wg = wgate + E * D * FF; const float* Wu = wup + E * D * FF; const float* Wd = wdown + E * FF * D;
        float g = 0.f, u = 0.f;
        for (int k = 0; k < D; ++k) { const float xv = xs[k]; g = fmaf(xv, Wg[(long)k * FF + tid], g); u = fmaf(xv, Wu[(long)k * FF + tid], u); }
        hb[tid] = (g / (1.f + expf(-g))) * u * cw;
        __syncthreads();
        for (int f = 0; f < FF; ++f) { const float hv = hb[f];
#pragma unroll
            for (int i = 0; i < 4; ++i) o[i] = fmaf(hv, Wd[(long)f * D + tid + 512 * i], o[i]); }
        __syncthreads();
    }
    float v[4]; float sm = 0.f;
#pragma unroll
    for (int i = 0; i < 4; ++i) { v[i] = ALPHA * xs[tid + 512 * i] + o[i]; sm += v[i]; }
    sm = wsum(sm); if (lane == 0) red[w] = sm; __syncthreads();
    float mean = 0.f; for (int i = 0; i < 8; ++i) mean += red[i]; mean *= (1.f / D);
    float q = 0.f;
#pragma unroll
    for (int i = 0; i < 4; ++i) { const float d = v[i] - mean; q += d * d; }
    q = wsum(q); if (lane == 0) red[8 + w] = q; __syncthreads();
    float var = 0.f; for (int i = 0; i < 8; ++i) var += red[8 + i]; var *= (1.f / D);
    const float rstd = rsqrtf(var + LN_EPS);
#pragma unroll
    for (int i = 0; i < 4; ++i) { const int c = tid + 512 * i; out[row * D + c] = (v[i] - mean) * rstd * gain[c] + bias[c]; }
}
__global__ __launch_bounds__(256) void rotary(float* __restrict__ proj) {
    const long idx = (long)blockIdx.x * 256 + threadIdx.x;
    const int i = idx & 127, h = (idx >> 7) & 7, qk = (idx >> 10) & 1; const long t = idx >> 11;
    const double freq = exp(-(double)i / 128.0 * 9.210340371976184);
    const double ang = (double)t * freq;
    const double kk = rint(ang * 0.15915494309189535); const double rr = ang - kk * 6.283185307179586;
    const float cs = (float)cos(rr), sn = (float)sin(rr);
    float* p = proj + t * RPROJ + qk * 2048 + h * 256 + i;
    const float t1 = p[0], t2 = p[128]; const float sc = qk ? 0.0625f : 1.f;
    p[0] = (t1 * cs - t2 * sn) * sc; p[128] = (t1 * sn + t2 * cs) * sc;
}
__global__ __launch_bounds__(256) void decay_mask(float* __restrict__ Sc, const float* __restrict__ dfw, const float* __restrict__ dbw) {
    const long idx = (long)blockIdx.x * 256 + threadIdx.x;
    const int m = idx & 2047, n = (idx >> 11) & 2047, h = idx >> 22;
    const float lgf = log1pf(-expf(dfw[h])), lgb = log1pf(-expf(dbw[h]));
    const float d = (m <= n) ? expf(lgf * (float)(n - m)) : expf(lgb * (float)(m - n));
    Sc[idx] *= d;
}
__global__ __launch_bounds__(256) void gn_gate(const float* __restrict__ y, const float* __restrict__ proj, float* __restrict__ z) {
    const int w = threadIdx.x >> 6, lane = threadIdx.x & 63; const long item = (long)blockIdx.x * 4 + w; const long t = item >> 3; const int h = item & 7;
    float v[8]; float q = 0.f;
#pragma unroll
    for (int i = 0; i < 8; ++i) { v[i] = y[t * RVW + h * RV + lane + 64 * i]; q += v[i] * v[i]; }
    q = wsum(q); const float r = rsqrtf(q * (1.f / RV) + GN_EPS);
#pragma unroll
    for (int i = 0; i < 8; ++i) { const float g = proj[t * RPROJ + 8192 + h * RV + lane + 64 * i]; z[t * RVW + h * RV + lane + 64 * i] = (g / (1.f + expf(-g))) * v[i] * r; }
}
struct In { const float *x, *awin, *awout, *rpb, *rwin, *rwout, *dfw, *dbw, *wgr, *bgr, *wer, *ber, *wgate, *wup, *wdown, *lng, *lnb; };
static void forward(const In& I, float* out, float* ws, hipStream_t st, int b_lo = 0, int b_hi = 8) {
    float* qkv = ws;
    float* proj = ws;
    float* ao = ws + (size_t)2048 * 12288;
    float* yret = ao;
    float* zb = yret + (size_t)2048 * 4096;
    float* mix = zb + (size_t)2048 * 4096;
    float* x1 = mix + (size_t)2048 * 2048;
    float* x2 = x1 + (size_t)2048 * 2048;
    float* x3 = x2 + (size_t)2048 * 2048;
    float* Sc = x3 + (size_t)2048 * 2048;
    const size_t MW = (size_t)NG * NE * D * FF;
    for (int b = b_lo; b < b_hi; ++b) {
        const float* xb = I.x + (size_t)b * S * D;
        hipLaunchKernelGGL(gemm, dim3(6144 / 64, 2048 / 64, 1), dim3(256), 0, st, xb, (long)D, 1L, 0L, I.awin, 6144L, 1L, 0L, qkv, 6144L, 0L, D);
        hipLaunchKernelGGL(natten, dim3(2048 * 4), dim3(256), 0, st, qkv, I.rpb, ao);
        hipLaunchKernelGGL(gemm, dim3(2048 / 64, 2048 / 64, 1), dim3(256), 0, st, ao, (long)D, 1L, 0L, I.awout, (long)D, 1L, 0L, mix, (long)D, 0L, D);
        hipLaunchKernelGGL(ln_res, dim3(2048), dim3(256), 0, st, xb, mix, I.lng + 0 * D, I.lnb + 0 * D, x1);
        hipLaunchKernelGGL(moe_ln, dim3(2048), dim3(512), 0, st, x1, I.wgr, I.bgr, I.wer, I.ber, I.wgate, I.wup, I.wdown, I.lng + 1 * D, I.lnb + 1 * D, x2);
        hipLaunchKernelGGL(gemm, dim3(RPROJ / 64, 2048 / 64, 1), dim3(256), 0, st, x2, (long)D, 1L, 0L, I.rwin, (long)RPROJ, 1L, 0L, proj, (long)RPROJ, 0L, D);
        hipLaunchKernelGGL(rotary, dim3(2048 * 2 * 8 * 128 / 256), dim3(256), 0, st, proj);
        hipLaunchKernelGGL(gemm, dim3(2048 / 64, 2048 / 64, RH), dim3(256), 0, st, proj, (long)RPROJ, 1L, (long)RQK, proj + 2048, 1L, (long)RPROJ, (long)RQK, Sc, 2048L, (long)2048 * 2048, RQK);
        hipLaunchKernelGGL(decay_mask, dim3(8 * 2048 * 2048 / 256), dim3(256), 0, st, Sc, I.dfw, I.dbw);
        hipLaunchKernelGGL(gemm, dim3(RV / 64, 2048 / 64, RH), dim3(256), 0, st, Sc, 2048L, 1L, (long)2048 * 2048, proj + 4096, (long)RPROJ, 1L, (long)RV, yret, (long)RVW, (long)RV, 2048);
        hipLaunchKernelGGL(gn_gate, dim3(2048 * 8 / 4), dim3(256), 0, st, yret, proj, zb);
        hipLaunchKernelGGL(gemm, dim3(2048 / 64, 2048 / 64, 1), dim3(256), 0, st, zb, (long)RVW, 1L, 0L, I.rwout, (long)D, 1L, 0L, mix, (long)D, 0L, RVW);
        hipLaunchKernelGGL(ln_res, dim3(2048), dim3(256), 0, st, x2, mix, I.lng + 2 * D, I.lnb + 2 * D, x3);
        hipLaunchKernelGGL(moe_ln, dim3(2048), dim3(512), 0, st, x3, I.wgr + D * NG, I.bgr + NG, I.wer + D * NG * NE, I.ber + NG * NE, I.wgate + MW, I.wup + MW, I.wdown + MW,
                           I.lng + 3 * D, I.lnb + 3 * D, out + (size_t)b * S * D);
    }
}
}
extern "C" void kernel_launch(void* const* d_in, const int* in_sizes, int n_in, void* d_out, int out_size, void* d_ws, size_t ws_size, hipStream_t stream) {
    if (n_in != 17 || out_size != 8 * 2048 * 2048 || ws_size < (size_t)400 * 1024 * 1024) { fprintf(stderr, "kernel_launch: unexpected shapes\n"); return; }
    nv::In I;
    I.x = (const float*)d_in[0]; I.awin = (const float*)d_in[1]; I.awout = (const float*)d_in[2]; I.rpb = (const float*)d_in[3];
    I.rwin = (const float*)d_in[4]; I.rwout = (const float*)d_in[5]; I.dfw = (const float*)d_in[6]; I.dbw = (const float*)d_in[7];
    I.wgr = (const float*)d_in[8]; I.bgr = (const float*)d_in[9]; I.wer = (const float*)d_in[10]; I.ber = (const float*)d_in[11];
    I.wgate = (const float*)d_in[12]; I.wup = (const float*)d_in[13]; I.wdown = (const float*)d_in[14]; I.lng = (const float*)d_in[15]; I.lnb = (const float*)d_in[16];
    nv::forward(I, (float*)d_out, (float*)d_ws, stream);
}
```

```cpp
#define DEBUG_STAGE 0
#include <hip/hip_runtime.h>
#include <cstdio>
#include <cstdint>
namespace pg8 {
#define PG8_LAS __attribute__((address_space(3)))
typedef unsigned short bf16_t;
typedef short bf16x8 __attribute__((ext_vector_type(8)));
typedef float f32x4 __attribute__((ext_vector_type(4)));
typedef float f32x2 __attribute__((ext_vector_type(2)));
typedef unsigned u32x4 __attribute__((ext_vector_type(4)));
typedef unsigned u32x2 __attribute__((ext_vector_type(2)));
constexpr int BM = 256, BK = 64, HALF = 128, HTB = HALF * BK * 2  , STAGE_BYTES = 8 * HTB, NXCD = 8, WGM = 8;

__host__ __device__ __forceinline__ int lds_byte(int r, int c) { const int st = (r >> 4) * 2 + (c >> 5), rr = r & 15, cc = c & 31, ob = rr * 64 + cc * 2; return st * 1024 + (ob ^ (((ob >> 9) & 1) << 5)); }
__host__ __device__ __forceinline__ void stage_rc(int b, int& R, int& C) { const int st = b / 1024, sb = b % 1024, swz = sb ^ (((sb >> 9) & 1) << 5); R = (st >> 1) * 16 + swz / 64; C = (st & 1) * 32 + (swz % 64) / 2; }
__host__ __device__ __forceinline__ int perm32(int rho) { const int n = rho >> 4, i = rho & 15; return 8 * (i >> 2) + 4 * n + (i & 3); }

struct Unit { int pm, pn, z, aux; };
struct Gemm { int lda, ldb, K; };
typedef int i32x4_t __attribute__((ext_vector_type(4)));
typedef int i32x8_t __attribute__((ext_vector_type(8)));
__device__ __forceinline__ i32x8_t cat8(bf16x8 a, bf16x8 b) { return __builtin_shufflevector(__builtin_bit_cast(i32x4_t, a), __builtin_bit_cast(i32x4_t, b), 0, 1, 2, 3, 4, 5, 6, 7); }
template <class S, class = void> struct sched_mode { static constexpr int v = 0; };
template <class S> struct sched_mode<S, decltype((void)S::MODE)> { static constexpr int v = S::MODE; };
__device__ __forceinline__ f32x4 i2f4(f32x4 a) { const i32x4_t i = __builtin_bit_cast(i32x4_t, a); return (f32x4){(float)i[0], (float)i[1], (float)i[2], (float)i[3]}; }

template <int NM, int NN, int ZZ, int MODE_ = 0> struct DenseOrderT {
    static constexpr bool GATHER = false, CARRY = false; static constexpr int MODE = MODE_;
    static constexpr int per_z = NM * NN, nwg = per_z * ZZ;
    const char* A; const char* B; size_t bsA, bsB, tA, tB;
    int G, c;
    __device__ void init(const void* A_, const void* B_, int lda, int ldb, size_t bsA_el, size_t bsB_el, int G_, int c_) {
        A = (const char*)A_; B = (const char*)B_; bsA = bsA_el * 2; bsB = bsB_el * 2; tA = (size_t)BM * lda * 2; tB = (size_t)BM * ldb * 2; G = G_; c = c_; }
    __device__ __forceinline__ bool next(int i, Unit& u) const {
        const int L = i * G + c; if (L >= nwg) return false;
        int wgid = L; { constexpr int q = nwg / NXCD, r = nwg % NXCD; const int xcd = wgid % NXCD, off = wgid / NXCD; wgid = (xcd < r ? xcd * (q + 1) : r * (q + 1) + (xcd - r) * q) + off; }
        u.z = wgid / per_z; wgid -= u.z * per_z;
        constexpr int nig = WGM * NN; const int gid = wgid / nig, fm = gid * WGM, gsz = (NM - fm) < WGM ? (NM - fm) : WGM;
        static_assert(NM % WGM == 0, "row tiles in whole groups of 8");
        u.pm = fm + ((wgid % nig) % WGM); u.pn = (wgid % nig) / WGM; u.aux = 0; (void)gsz; return true;
    }
    __device__ __forceinline__ const char* abase(const Unit& u) const { return A + (size_t)u.z * bsA + (size_t)u.pm * tA; }
    __device__ __forceinline__ const char* bbase(const Unit& u) const { return B + (size_t)u.z * bsB + (size_t)u.pn * tB; }
    __device__ __forceinline__ unsigned arow(const Unit&, int r) const { return (unsigned)r; }
    __device__ __forceinline__ void a_ready(const Unit&) const {}
    __device__ __forceinline__ void done(const Unit&) const {}
};

__device__ __forceinline__ unsigned cvt_pk_bf16(float lo, float hi) { unsigned r; asm volatile("v_cvt_pk_bf16_f32 %0, %1, %2" : "=v"(r) : "v"(lo), "v"(hi)); return r; }
__device__ __forceinline__ float bf_lo(unsigned w) { return __uint_as_float(w << 16); }
__device__ __forceinline__ float bf_hi(unsigned w) { return __uint_as_float(w & 0xffff0000u); }
__device__ __forceinline__ float silu_f(float v) { return v * __builtin_amdgcn_rcpf(1.0f + __builtin_amdgcn_exp2f(-1.44269504f * v)); }

template <int ACT, bool NT = false> struct EpiBf16 {
    static constexpr bool PERM = true;
    bf16_t* O; int ldc; int split_cols; size_t split_stride; float scale0; size_t zstride; float gs = 1.f;
    __device__ __forceinline__ void operator()(const f32x4 (&acc)[2][2][4][2], const Unit& u, int wr, int wc, int fr, int fq) const {
        const int row0 = u.pm * BM + wr * 64 + fr; int colt = u.pn * BM; bf16_t* base = O + (size_t)u.z * zstride;
        float sc = gs; if (split_cols) { const int t = colt / split_cols; base += (size_t)t * split_stride; colt -= t * split_cols; if (t == 0) sc = scale0 * gs; }
        const int col0 = colt + wc * 32 + 8 * fq;
#pragma unroll
        for (int ai = 0; ai < 2; ++ai)
#pragma unroll
            for (int m = 0; m < 4; ++m) { bf16_t* rowp = base + (size_t)(row0 + ai * HALF + m * 16) * ldc + col0;
#pragma unroll
                for (int bj = 0; bj < 2; ++bj) { f32x4 v0 = acc[ai][bj][m][0], v1 = acc[ai][bj][m][1];
                    if (ACT == 3) {
#pragma unroll
                        for (int j = 0; j < 4; ++j) { v0[j] = silu_f(v0[j]); v1[j] = silu_f(v1[j]); } }
                    v0 = v0 * sc; v1 = v1 * sc; u32x4 w; w.x = cvt_pk_bf16(v0[0], v0[1]); w.y = cvt_pk_bf16(v0[2], v0[3]); w.z = cvt_pk_bf16(v1[0], v1[1]); w.w = cvt_pk_bf16(v1[2], v1[3]);
                    if (NT) __builtin_nontemporal_store(w, (u32x4*)(rowp + bj * HALF)); else *(u32x4*)(rowp + bj * HALF) = w; } }
    }
};

template <class Epi, class Sched, bool ALIGN_EPI>
__device__ __forceinline__ void gemm_phase(PG8_LAS unsigned char* lds, const Gemm g, const Sched& S, const Epi& E) {
    int tid_ = threadIdx.x; asm volatile("" : "+v"(tid_));
    const int tid = tid_, wid = __builtin_amdgcn_readfirstlane(tid >> 6), lane = tid & 63, wr = wid >> 2, wc = wid & 3, fr = lane & 15, fq = lane >> 4;
    const int K = g.K, nt = K / BK;
    int Rr[2], Cc[2]; unsigned voffB[2];
#pragma unroll
    for (int i = 0; i < 2; ++i) { int R, C; stage_rc(tid * 16 + i * 8192, R, C); const int Rb = Epi::PERM ? ((R & ~31) + perm32(R & 31)) : R; Rr[i] = R; Cc[i] = C; voffB[i] = (unsigned)(Rb * g.ldb + C) * 2u; }
    const size_t kstep = (size_t)(BK * 2);
    const size_t hstepB = (size_t)HALF * g.ldb * 2;
    const unsigned ldsw = (unsigned)wid * 1024u;
    const int aoff = lds_byte(wr * 64 + fr, fq * 8), boff = lds_byte(wc * 32 + fr, fq * 8);
#define PG8_SA(b, h) (((b) * 2 + (h)) * HTB)
#define PG8_SB(b, h) ((4 + (b) * 2 + (h)) * HTB)
#define PG8_STAGE2(bufoff, gbase, v0, v1) do { \
        __builtin_amdgcn_global_load_lds((const unsigned*)((const char*)(gbase) + (v0)), (PG8_LAS unsigned*)(lds + (bufoff) + ldsw), 16, 0, 0); \
        __builtin_amdgcn_global_load_lds((const unsigned*)((const char*)(gbase) + (v1)), (PG8_LAS unsigned*)(lds + (bufoff) + ldsw + 8192), 16, 0, 0); } while (0)
#define PG8_STAGEB(bufoff, gbase) PG8_STAGE2(bufoff, gbase, voffB[0], voffB[1])
#define PG8_STAGEA_C(bufoff, gbase, h) PG8_STAGE2(bufoff, gbase, vAc[h][0], vAc[h][1])
#define PG8_STAGEA_X(bufoff, gbase, h) PG8_STAGE2(bufoff, gbase, (last ? vAn[h][0] : vAc[h][0]), (last ? vAn[h][1] : vAc[h][1]))
#define PG8_LDA(dst, b, h) do { _Pragma("unroll") for (int m = 0; m < 4; ++m) _Pragma("unroll") for (int k = 0; k < 2; ++k) dst[m][k] = *(const PG8_LAS bf16x8*)(lds + PG8_SA(b, h) + aoff + m * 2048 + k * 1024); } while (0)
#define PG8_LDB(dst, b, h) do { _Pragma("unroll") for (int n = 0; n < 2; ++n) _Pragma("unroll") for (int k = 0; k < 2; ++k) dst[n][k] = *(const PG8_LAS bf16x8*)(lds + PG8_SB(b, h) + boff + n * 2048 + k * 1024); } while (0)
#define PG8_MMA(ai, bj, At, Bt) do { __builtin_amdgcn_s_setprio(1); \
        if constexpr (sched_mode<Sched>::v == 2) { _Pragma("unroll") for (int m = 0; m < 4; ++m) _Pragma("unroll") for (int n = 0; n < 2; ++n) _Pragma("unroll") for (int k = 0; k < 2; ++k) \
            acc[ai][bj][m][n] = __builtin_bit_cast(f32x4, __builtin_amdgcn_mfma_i32_16x16x64_i8(__builtin_bit_cast(i32x4_t, Bt[n][k]), __builtin_bit_cast(i32x4_t, At[m][k]), __builtin_bit_cast(i32x4_t, acc[ai][bj][m][n]), 0, 0, 0)); } \
        else if constexpr (sched_mode<Sched>::v == 1) { _Pragma("unroll") for (int m = 0; m < 4; ++m) _Pragma("unroll") for (int n = 0; n < 2; ++n) \
            asm volatile("v_mfma_scale_f32_16x16x128_f8f6f4 %0, %1, %2, %0, %3, %3 op_sel_hi:[0,0,0]" : "+v"(acc[ai][bj][m][n]) : "v"(cat8(Bt[n][0], Bt[n][1])), "v"(cat8(At[m][0], At[m][1])), "v"(f8one)); } \
        else { _Pragma("unroll") for (int m = 0; m < 4; ++m) _Pragma("unroll") for (int n = 0; n < 2; ++n) _Pragma("unroll") for (int k = 0; k < 2; ++k) \
            acc[ai][bj][m][n] = __builtin_amdgcn_mfma_f32_16x16x32_bf16(Bt[n][k], At[m][k], acc[ai][bj][m][n], 0, 0, 0); } \
        __builtin_amdgcn_s_setprio(0); } while (0)
#define PG8_WAIT_V(n) asm volatile("s_waitcnt vmcnt(" #n ")" ::: "memory")
#define PG8_WAIT_L(n) asm volatile("s_waitcnt lgkmcnt(" #n ")" ::: "memory")
#define PG8_BAR __builtin_amdgcn_s_barrier()
#define PG8_SCHED __builtin_amdgcn_sched_barrier(0)
#define PG8_AOFFS(dst, u) do { _Pragma("unroll") for (int h = 0; h < 2; ++h) _Pragma("unroll") for (int i = 0; i < 2; ++i) dst[h][i] = (S.arow(u, h * HALF + Rr[i]) * (unsigned)g.lda + (unsigned)Cc[i]) * 2u; } while (0)
    Unit cur, nxt; int ui = 0;
    const int f8one = 0x7f7f7f7f; (void)f8one;
    if (!S.next(0, cur)) return;
    f32x4 acc[2][2][4][2];
#pragma unroll
    for (int a = 0; a < 2; ++a)
#pragma unroll
        for (int b = 0; b < 2; ++b)
#pragma unroll
            for (int m = 0; m < 4; ++m)
#pragma unroll
                for (int n = 0; n < 2; ++n) acc[a][b][m][n] = (f32x4){0.f, 0.f, 0.f, 0.f};
    bf16x8 At[4][2], B0[2][2], B1[2][2];
    unsigned vAc[2][2], vAn[2][2];
    PG8_AOFFS(vAc, cur);
    const char* cA = S.abase(cur); const char* cB = S.bbase(cur);
    S.a_ready(cur);
    PG8_STAGEB(PG8_SB(0, 0), cB); PG8_STAGEB(PG8_SB(0, 1), cB + hstepB); PG8_STAGEA_C(PG8_SA(0, 0), cA, 0); PG8_STAGEA_C(PG8_SA(0, 1), cA, 1);
    if (wr == 1) PG8_BAR;
    PG8_WAIT_V(2); PG8_BAR;
    PG8_STAGEB(PG8_SB(1, 0), cB + kstep); PG8_STAGEA_C(PG8_SA(1, 0), cA + kstep, 0); PG8_STAGEB(PG8_SB(1, 1), cB + hstepB + kstep);
    PG8_WAIT_V(6); PG8_BAR;
    for (;;) {
        const bool has_next = S.next(ui + 1, nxt);
        const char* nA = cA; const char* nB = cB;
        if (has_next) { nA = S.abase(nxt); nB = S.bbase(nxt); PG8_AOFFS(vAn, nxt); }
        else {
#pragma unroll
            for (int h = 0; h < 2; ++h)
#pragma unroll
                for (int i = 0; i < 2; ++i) vAn[h][i] = vAc[h][i]; }
#pragma nounroll
        for (int t = 0; t < nt; t += 2) {
            const bool last = (t == nt - 2);
            const char* a1 = cA + (size_t)(t + 1) * kstep;
            const char* a2 = last ? nA : cA + (size_t)(t + 2) * kstep; const char* b2 = last ? nB : cB + (size_t)(t + 2) * kstep;
            const char* a3 = a2 + kstep; const char* b3 = b2 + kstep;
            if (last && has_next) S.a_ready(nxt);
            PG8_LDB(B0, 0, 0); PG8_LDB(B1, 0, 1); PG8_SCHED; PG8_LDA(At, 0, 0); PG8_STAGEA_C(PG8_SA(1, 1), a1, 1);
            PG8_WAIT_V(8); PG8_WAIT_L(0); PG8_BAR; PG8_MMA(0, 0, At, B0); PG8_MMA(0, 1, At, B1); PG8_BAR; PG8_SCHED;
            PG8_LDA(At, 0, 1); PG8_STAGEB(PG8_SB(0, 0), b2); PG8_STAGEB(PG8_SB(0, 1), b2 + hstepB); PG8_STAGEA_X(PG8_SA(0, 0), a2, 0);
            PG8_WAIT_V(8); PG8_WAIT_L(0); PG8_BAR; PG8_MMA(1, 0, At, B0); PG8_MMA(1, 1, At, B1); PG8_BAR; PG8_SCHED;
            PG8_LDB(B0, 1, 0); PG8_LDB(B1, 1, 1); PG8_SCHED; PG8_LDA(At, 1, 0); PG8_STAGEA_X(PG8_SA(0, 1), a2, 1);
            PG8_WAIT_V(8); PG8_WAIT_L(0); PG8_BAR; PG8_MMA(0, 0, At, B0); PG8_MMA(0, 1, At, B1); PG8_BAR; PG8_SCHED;
            PG8_LDA(At, 1, 1); PG8_STAGEB(PG8_SB(1, 0), b3); PG8_STAGEB(PG8_SB(1, 1), b3 + hstepB); PG8_STAGEA_X(PG8_SA(1, 0), a3, 0);
            PG8_WAIT_V(8); PG8_WAIT_L(0); PG8_BAR; PG8_MMA(1, 0, At, B0); PG8_MMA(1, 1, At, B1); PG8_BAR; PG8_SCHED;
        }
        if constexpr (sched_mode<Sched>::v == 1) asm volatile("s_nop 15\n\ts_nop 15" ::: "memory");
        if constexpr (ALIGN_EPI) { if (wr == 0) PG8_BAR; }
        E(acc, cur, wr, wc, fr, fq); S.done(cur);
        if (!has_next) break;
#pragma unroll
        for (int a = 0; a < 2; ++a)
#pragma unroll
            for (int m = 0; m < 4; ++m) { float cf = 0.f; if constexpr (Sched::CARRY) cf = S.carry(cur, nxt, a * HALF + wr * 64 + m * 16 + fr);
#pragma unroll
                for (int b = 0; b < 2; ++b)
#pragma unroll
                    for (int n = 0; n < 2; ++n) { if constexpr (Sched::CARRY) acc[a][b][m][n] = acc[a][b][m][n] * cf; else acc[a][b][m][n] = (f32x4){0.f, 0.f, 0.f, 0.f}; } }
        cur = nxt; cA = nA; cB = nB; ++ui;
#pragma unroll
        for (int h = 0; h < 2; ++h)
#pragma unroll
            for (int i = 0; i < 2; ++i) vAc[h][i] = vAn[h][i];
        if constexpr (ALIGN_EPI) { if (wr == 1) PG8_BAR; }
    }
    PG8_WAIT_V(0);
    if constexpr (!ALIGN_EPI) { if (wr == 0) PG8_BAR; }
    PG8_BAR;
#undef PG8_SA
#undef PG8_SB
#undef PG8_STAGE2
#undef PG8_STAGEB
#undef PG8_STAGEA_C
#undef PG8_STAGEA_X
#undef PG8_LDA
#undef PG8_LDB
#undef PG8_MMA
#undef PG8_WAIT_V
#undef PG8_WAIT_L
#undef PG8_BAR
#undef PG8_SCHED
#undef PG8_AOFFS
}
}
#define GAS __attribute__((address_space(1)))
#define LAS __attribute__((address_space(3)))
typedef unsigned short bf16;
typedef unsigned v4u __attribute__((ext_vector_type(4)));
typedef float f32x4 __attribute__((ext_vector_type(4)));
typedef short bf16x8 __attribute__((ext_vector_type(8)));
typedef GAS unsigned gu32;
typedef GAS unsigned long long gu64;
#define RLX_AGENT __ATOMIC_RELAXED, __HIP_MEMORY_SCOPE_AGENT
#define LDS_WAIT() asm volatile("s_waitcnt lgkmcnt(0)" ::: "memory")
#define VM_WAIT() asm volatile("s_waitcnt vmcnt(0)" ::: "memory")
__device__ __forceinline__ unsigned long long rt() { return __builtin_amdgcn_s_memrealtime(); }
__device__ __forceinline__ unsigned f2bf(float f) { unsigned u = __builtin_bit_cast(unsigned, f); return (u + 0x7fffu + ((u >> 16) & 1u)) >> 16; }
__device__ __forceinline__ unsigned pk2(float lo, float hi) { return f2bf(lo) | (f2bf(hi) << 16); }

#define XB_TMO      128
#define XB_XCNT(j)  (256  + 64 * (j))
#define XB_XSUB(j)  (1280 + 64 * (j))
#define XB_XGEN(j)  (2304 + 64 * (j))
#define XB_TOP      3328
#define XB_TOPGEN   3392
#define XCD_BAR_WORDS 3456
#define XB_SPIN_CAP (1u << 18)

__device__ __forceinline__ unsigned xb_ld(unsigned* p)              { return __hip_atomic_load(p, __ATOMIC_RELAXED, __HIP_MEMORY_SCOPE_AGENT); }
__device__ __forceinline__ unsigned xb_add(unsigned* p, unsigned v) { return __hip_atomic_fetch_add(p, v, __ATOMIC_RELAXED, __HIP_MEMORY_SCOPE_AGENT); }
__device__ __forceinline__ unsigned xb_xcc_id() { return (unsigned)__builtin_amdgcn_s_getreg((3 << 11) | 20) & 0xFu; }
#define XB_SPIN(cond, bar) do { unsigned _sp = 0; while (cond) { __builtin_amdgcn_s_sleep(1); \
    if ((++_sp & 255u) == 0u) { if (xb_ld(&(bar)[XB_TMO])) break; if (_sp > XB_SPIN_CAP) { atomicAdd(&(bar)[XB_TMO], 1u); break; } } } } while (0)

struct XcdBarrier {
    unsigned* bar; unsigned x;
    volatile LAS unsigned* st;
};

__device__ __forceinline__ XcdBarrier xcd_barrier_post(unsigned* bar, volatile LAS unsigned* st) {
    XcdBarrier b; b.bar = bar; b.x = xb_xcc_id(); b.st = st;
    if (threadIdx.x == 0) (void)xb_add(&bar[XB_XCNT(b.x)], 1u);
    return b;
}
__device__ __forceinline__ void xcd_barrier_complete(unsigned* bar, unsigned x, unsigned& nloc, unsigned& nx) {
    const unsigned G = gridDim.x * gridDim.y * gridDim.z;
    unsigned sum, cnt, mine, sp = 0u;
    for (;;) {
        sum = 0u; cnt = 0u; mine = 0u;
#pragma unroll
        for (unsigned j = 0; j < 16; ++j) { const unsigned c = xb_ld(&bar[XB_XCNT(j)]); sum += c; cnt += (c > 0u) ? 1u : 0u; mine = (j == x) ? c : mine; }
        if (sum == G) break;
        __builtin_amdgcn_s_sleep(1);
        if ((++sp & 255u) == 0u) { if (xb_ld(&bar[XB_TMO])) break; if (sp > XB_SPIN_CAP) { atomicAdd(&bar[XB_TMO], 1u); break; } }
    }
    nloc = mine > 0u ? mine : 1u; nx = cnt > 0u ? cnt : 1u;
}

__device__ __forceinline__ void xcd_barrier(const XcdBarrier& b) {
    asm volatile("s_waitcnt vmcnt(0)" ::: "memory");
    __syncthreads();
    if (threadIdx.x == 0) {
        unsigned* bar = b.bar;
        __builtin_amdgcn_s_waitcnt(0);
        unsigned nloc = b.st[0], nx = b.st[1];
        if (nloc == 0u) { xcd_barrier_complete(bar, b.x, nloc, nx); b.st[0] = nloc; b.st[1] = nx; }
        const unsigned old = xb_add(&bar[XB_XSUB(b.x)], 1u);
        const unsigned gen = old / nloc;
        if (old + 1u == (gen + 1u) * nloc) {
            __builtin_amdgcn_fence(__ATOMIC_RELEASE, "agent");
            asm volatile("s_waitcnt vmcnt(0)" ::: "memory");
            const unsigned og = xb_add(&bar[XB_TOP], 1u);
            const unsigned tg = og / nx;
            if (og + 1u == (tg + 1u) * nx) xb_add(&bar[XB_TOPGEN], 1u);
            else XB_SPIN(xb_ld(&bar[XB_TOPGEN]) == tg, bar);
            __builtin_amdgcn_fence(__ATOMIC_ACQUIRE, "agent");
            xb_add(&bar[XB_XGEN(b.x)], 1u);
            asm volatile("s_waitcnt vmcnt(0)" ::: "memory");
        } else {
            XB_SPIN(xb_ld(&bar[XB_XGEN(b.x)]) == gen, bar);
            __builtin_amdgcn_fence(__ATOMIC_ACQUIRE, "agent");
            asm volatile("s_waitcnt vmcnt(0)" ::: "memory");
        }
    }
    __syncthreads();
}

#ifndef REPEAT_MASK
#define REPEAT_MASK 0u
#endif
constexpr int NWAVES = 8;
constexpr int BATCH = 8, SEQ = 2048, D = 2048, M = BATCH * SEQ;
constexpr int NHA = 16, DHA = 128, GW = 64, GROWS = 32;
constexpr int RH = 8, RQK = 256, RV = 512, RVW = 4096, RPROJ = 12288;
constexpr int NEXP = 32, FF = 512;
constexpr float ALPHA = 1.41421356237309515f, LN_EPS = 1e-5f, GN_EPS = 1e-6f;
constexpr size_t MiB = 1u << 20;
constexpr size_t WS_CTL = 0, CTL_ZERO_BYTES = 2 * MiB;
constexpr size_t WS_TAB = 2 * MiB;
constexpr size_t WS_ROTD = WS_TAB + 3 * MiB + 4096;
constexpr size_t WS_SX = WS_TAB + 4 * MiB;
constexpr size_t WS_X2I8 = 8 * MiB;
constexpr size_t WS_WAIN = 8 * MiB, WS_WAOUT = 32 * MiB, WS_WRIN = 40 * MiB, WS_WROUT = 88 * MiB, WS_WM1 = 104 * MiB, WS_WM2 = 232 * MiB;
constexpr size_t WS_A0 = 296 * MiB, WS_A1 = 360 * MiB, WS_A2 = 424 * MiB, WS_A3 = 488 * MiB, WS_A4 = 552 * MiB, WS_A5 = 616 * MiB, WS_A6 = 744 * MiB, WS_MISC = 872 * MiB, WS_FAST_END = 1008 * MiB;
constexpr size_t WS_DBG1 = 888 * MiB, WS_DBG2 = 984 * MiB, WS_END = 1080 * MiB;
constexpr size_t WS_PB1 = 880 * MiB;
constexpr int CW_TMO = 0, CW_CODE = 1;
constexpr int CW_DBG = 64;
constexpr int CW_BAR = 4096;
constexpr int CW_CNT = 8192;
constexpr int CW_FSC = 16384;
constexpr int CW_STATS = 65536;
static_assert((CW_STATS + 4 * 2 * 16384) * 4 <= (int)CTL_ZERO_BYTES, "CTL words inside the memset region");
constexpr int RING_OFF = 0, RING_BYTES = 131072;
constexpr int LDSCTL_OFF = RING_BYTES, MISC_OFF = LDSCTL_OFF + 320;
constexpr int LDS_BYTES = 147456;
static_assert(MISC_OFF + 128 <= LDS_BYTES, "LDS map");
struct Ins; struct Frame;
__device__ __forceinline__ void build_router_frags(const Ins& I, Frame& F);
__device__ __forceinline__ void build_decay_table(const Ins& I, Frame& F);
typedef unsigned short bf16;
struct Frame {
    LAS unsigned char* lds;
    volatile LAS unsigned* MISC;
    gu32* ctl;
    int tid, lane, wave;
    int vcu, G;
    unsigned char* ws;
};
__device__ __forceinline__ float wave_sum(float v) {
#pragma unroll
    for (int o = 1; o < 64; o <<= 1) v += __shfl_xor(v, o);
    return v;
}
__device__ __forceinline__ void tr_item(const float* W, int ldw, int k0, int n0, bf16* WT, int ldt, int drow0, LAS float* scr, int lane) {
    f32x4 v[8];
#pragma unroll
    for (int i = 0; i < 8; ++i) v[i] = __builtin_nontemporal_load((const GAS f32x4*)(W + (size_t)(k0 + (lane >> 3) + 8 * i) * ldw + n0 + (lane & 7) * 4));
#pragma unroll
    for (int i = 0; i < 8; ++i) { LAS float* d = scr + ((lane >> 3) + 8 * i) * 33 + (lane & 7) * 4; d[0] = v[i].x; d[1] = v[i].y; d[2] = v[i].z; d[3] = v[i].w; }
    LDS_WAIT(); asm volatile("" ::: "memory");
    const int c = lane & 7;
#pragma unroll
    for (int j = 0; j < 4; ++j) { const int n = (lane >> 3) + 8 * j; const LAS float* s = scr + (8 * c) * 33 + n;
        v4u o; o.x = pk2(s[0 * 33], s[1 * 33]); o.y = pk2(s[2 * 33], s[3 * 33]); o.z = pk2(s[4 * 33], s[5 * 33]); o.w = pk2(s[6 * 33], s[7 * 33]);
        __builtin_nontemporal_store(o, (GAS v4u*)(WT + (size_t)(drow0 + n) * ldt + k0 + 8 * c)); }
    LDS_WAIT(); asm volatile("" ::: "memory");
}
__device__ __forceinline__ unsigned pk4_fp8(float a, float b, float c, float d) {
    a = __builtin_fminf(__builtin_fmaxf(a, -448.f), 448.f); b = __builtin_fminf(__builtin_fmaxf(b, -448.f), 448.f); c = __builtin_fminf(__builtin_fmaxf(c, -448.f), 448.f); d = __builtin_fminf(__builtin_fmaxf(d, -448.f), 448.f);
    int w = 0; w = __builtin_amdgcn_cvt_pk_fp8_f32(a, b, w, false); w = __builtin_amdgcn_cvt_pk_fp8_f32(c, d, w, true); return (unsigned)w; }
__device__ __forceinline__ unsigned pk4_i8(float a, float b, float c, float d) {
    const int ia = (int)__builtin_rintf(__builtin_fminf(__builtin_fmaxf(a, -127.f), 127.f)), ib = (int)__builtin_rintf(__builtin_fminf(__builtin_fmaxf(b, -127.f), 127.f));
    const int ic = (int)__builtin_rintf(__builtin_fminf(__builtin_fmaxf(c, -127.f), 127.f)), id = (int)__builtin_rintf(__builtin_fminf(__builtin_fmaxf(d, -127.f), 127.f));
    return ((unsigned)ia & 255u) | (((unsigned)ib & 255u) << 8) | (((unsigned)ic & 255u) << 16) | ((unsigned)id << 24); }
template <bool I8 = false>
__device__ __forceinline__ void tr_item8(const float* W, int ldw, int k0, int n0, unsigned char* WT, int ldt, int drow0, LAS float* scr, int lane, float mul) {
    f32x4 v[8];
#pragma unroll
    for (int i = 0; i < 8; ++i) v[i] = __builtin_nontemporal_load((const GAS f32x4*)(W + (size_t)(k0 + (lane >> 3) + 8 * i) * ldw + n0 + (lane & 7) * 4));
#pragma unroll
    for (int i = 0; i < 8; ++i) { LAS float* d = scr + ((lane >> 3) + 8 * i) * 33 + (lane & 7) * 4; d[0] = v[i].x * mul; d[1] = v[i].y * mul; d[2] = v[i].z * mul; d[3] = v[i].w * mul; }
    LDS_WAIT(); asm volatile("" ::: "memory");
#pragma unroll
    for (int j = 0; j < 2; ++j) { const int task = lane + 64 * j, n = task >> 2, c = task & 3; const LAS float* s = scr + (16 * c) * 33 + n;
        v4u o;
        if (I8) { o.x = pk4_i8(s[0 * 33], s[1 * 33], s[2 * 33], s[3 * 33]); o.y = pk4_i8(s[4 * 33], s[5 * 33], s[6 * 33], s[7 * 33]); o.z = pk4_i8(s[8 * 33], s[9 * 33], s[10 * 33], s[11 * 33]); o.w = pk4_i8(s[12 * 33], s[13 * 33], s[14 * 33], s[15 * 33]); }
        else { o.x = pk4_fp8(s[0 * 33], s[1 * 33], s[2 * 33], s[3 * 33]); o.y = pk4_fp8(s[4 * 33], s[5 * 33], s[6 * 33], s[7 * 33]); o.z = pk4_fp8(s[8 * 33], s[9 * 33], s[10 * 33], s[11 * 33]); o.w = pk4_fp8(s[12 * 33], s[13 * 33], s[14 * 33], s[15 * 33]); }
        __builtin_nontemporal_store(o, (GAS v4u*)(WT + (size_t)(drow0 + n) * ldt + k0 + 16 * c)); }
    LDS_WAIT(); asm volatile("" ::: "memory");
}
struct Ins { const float *x, *awin, *awout, *rpb, *rwin, *rwout, *dfw, *dbw, *wgr, *bgr, *wer, *ber, *wgate, *wup, *wdown, *lng, *lnb; };

__device__ __forceinline__ float fsc_mul(const Frame& F, int layer, int kind) { const int s = ((const GAS int*)F.ctl)[CW_FSC + layer * 2 + kind]; return __uint_as_float((unsigned)(127 + s) << 23); }
__device__ __forceinline__ void conv_moe_item(const Ins& I, Frame& F, int layer, int r, LAS float* scr) {
    const size_t MW = (size_t)NEXP * D * FF; unsigned char* W1 = F.ws + WS_WM1; unsigned char* W2 = F.ws + WS_WM2;
    if (r < 32768) { const int up = r >= 16384; const int q = r & 16383; const int E = q >> 9, kb = (q & 511) >> 4, nb = q & 15, n0 = nb * 32;
        const float* W = (up ? I.wup : I.wgate) + (size_t)layer * MW + (size_t)E * D * FF;
        tr_item8(W, FF, kb * 64, n0, W1 + (size_t)E * 1024 * D, D, 256 * (n0 >> 7) + (n0 & 127) + (up ? 128 : 0), scr, F.lane, fsc_mul(F, layer, 0)); return; }
    r -= 32768;
    { const int E = r >> 9, kb = (r & 511) >> 6, nb = r & 63, n0 = nb * 32;
        const float* W = I.wdown + (size_t)layer * MW + (size_t)E * FF * D;
        tr_item8(W, D, kb * 64, n0, W2 + (size_t)E * D * FF, FF, n0, scr, F.lane, fsc_mul(F, layer, 1)); }
}
__device__ __forceinline__ float sample_absmax(const float* T0, const float* T1, int ld, int c0, int width, int rows, Frame& F) {
    float sv[2][16]; float mx = 0.f; const size_t n = (size_t)rows * width;
#pragma unroll
    for (int j = 0; j < 16; ++j) { const size_t p = ((size_t)(F.tid * 16 + j) * 4099u) % n; const size_t q = (p / width) * ld + c0 + (p % width); sv[0][j] = T0[q]; sv[1][j] = T1[q]; }
#pragma unroll
    for (int j = 0; j < 16; ++j) mx = __builtin_fmaxf(mx, __builtin_fmaxf(__builtin_fabsf(sv[0][j]), __builtin_fabsf(sv[1][j])));
#pragma unroll
    for (int o = 1; o < 64; o <<= 1) mx = __builtin_fmaxf(mx, __shfl_xor(mx, o));
    LAS float* red = (LAS float*)(F.lds + RING_OFF);
    if (F.lane == 0) red[F.wave] = mx;
    __syncthreads();
    float m = 0.f;
#pragma unroll
    for (int w = 0; w < NWAVES; ++w) m = __builtin_fmaxf(m, red[w]);
    __syncthreads();
    return m;
}
__device__ __forceinline__ int sample_scale_exp(const float* T0, const float* T1, size_t n, Frame& F) {
    const float m = sample_absmax(T0, T1, 4096, 0, 4096, (int)(n / 4096), F);
    int s = 0; if (m > 0.f && m < 3.0e38f) { s = (int)floorf(log2f(28.0f / m)); s = s < -60 ? -60 : (s > 60 ? 60 : s); }
    return s;
}
__device__ __forceinline__ void moe_scale_estimate(const Ins& I, Frame& F) {
    if (blockIdx.x == 4) { const int s = sample_scale_exp(I.rwout, I.rwout, (size_t)RVW * D, F); if (F.tid == 0) ((GAS int*)F.ctl)[CW_FSC + 6] = s; return; }
    if (blockIdx.x >= 5 && blockIdx.x < 8) { const int part = blockIdx.x - 5;
        float m = 1.25f * sample_absmax(I.rwin, I.rwin, RPROJ, part == 0 ? 0 : 4096 * part, 4096, D, F); if (!(m > 0.f && m < 3.0e38f)) m = 1.f;
        if (F.tid == 0) ((GAS float*)F.ctl)[CW_FSC + 8 + part] = m; return; }
    if (blockIdx.x >= 4) return;
    const int layer = blockIdx.x >> 1, kind = blockIdx.x & 1; const size_t MW = (size_t)NEXP * D * FF;
    const int s = sample_scale_exp((kind ? I.wdown : I.wgate) + (size_t)layer * MW, (kind ? I.wdown : I.wup) + (size_t)layer * MW, MW, F);
    if (F.tid == 0) ((GAS int*)F.ctl)[CW_FSC + layer * 2 + kind] = s;
}
constexpr int MOE_ITEMS = 49152;

__device__ __forceinline__ void conv_ret(const Ins& I, Frame& F) {
    LAS float* scr = (LAS float*)(F.lds + RING_OFF + F.wave * 16384);
    constexpr int I_RIN = 32 * 384, I_ROUT = 64 * 64;
    for (int it = F.vcu * NWAVES + F.wave; it < I_RIN + I_ROUT; it += F.G * NWAVES) {
        int r = it;
        if (r < I_RIN) { const int kb = r / 384, nb = r % 384, n0 = nb * 32; const int dr = n0 < 4096 ? n0 : (n0 < 8192 ? n0 + 4096 : n0 - 4096);
            const float wm = ((const GAS float*)F.ctl)[CW_FSC + 8 + (n0 < 4096 ? 0 : (n0 < 8192 ? 1 : 2))];
            tr_item8<true>(I.rwin, RPROJ, kb * 64, n0, F.ws + WS_WRIN, D, dr, scr, F.lane, 127.f / wm); continue; } r -= I_RIN;
        { const int kb = r / 64, nb = r % 64; tr_item8(I.rwout, D, kb * 64, nb * 32, F.ws + WS_WROUT, RVW, nb * 32, scr, F.lane, fsc_mul(F, 3, 0)); }
    }
    __syncthreads();
}
__device__ __forceinline__ void conv_l1(const Ins& I, Frame& F, int lo, int hi) {
    LAS float* scr = (LAS float*)(F.lds + RING_OFF + F.wave * 16384);
    for (int it = lo + F.vcu * NWAVES + F.wave; it < hi; it += F.G * NWAVES) conv_moe_item(I, F, 1, it, scr);
    __syncthreads();
}
__device__ __forceinline__ void conv_l0(const Ins& I, Frame& F, int lo, int hi) {
    LAS float* scr = (LAS float*)(F.lds + RING_OFF + F.wave * 16384);
    for (int it = lo + F.vcu * NWAVES + F.wave; it < hi; it += F.G * NWAVES) conv_moe_item(I, F, 0, it, scr);
    __syncthreads();
}
__device__ __forceinline__ void conv_rest(const Ins& I, Frame& F) {
    conv_l0(I, F, 0, MOE_ITEMS / 2);
    build_router_frags(I, F);
    build_decay_table(I, F);
    float* tc = (float*)(F.ws + WS_TAB); float* tsn = tc + 2048 * 128;
    for (int idx = (F.vcu * NWAVES + F.wave) * 64 + F.lane; idx < 256 * 128; idx += F.G * NWAVES * 64) {
        const int i = idx & 127, r = idx >> 7, t = (r >> 5) * 256 + ((r >> 4) & 1) * 64 + (r & 15);
        const double freq = exp(-(double)i / 128.0 * 9.210340371976184);
        const double ang = (double)t * freq; const double kk = rint(ang * 0.15915494309189535); const double rr = ang - kk * 6.283185307179586;
        tc[t * 128 + i] = (float)cos(rr); tsn[t * 128 + i] = (float)sin(rr);
    }
    if (blockIdx.x == 1 && F.tid < 256) {
        const int i = F.tid & 127; const double freq = exp(-(double)i / 128.0 * 9.210340371976184), ang = (F.tid < 128 ? 16.0 : 128.0) * freq;
        float* rd = (float*)(F.ws + WS_ROTD) + (F.tid < 128 ? 0 : 256);
        rd[i] = (float)cos(ang); rd[128 + i] = (float)sin(ang); }
    __syncthreads();
}
__device__ __forceinline__ void p0_prologue(const Ins& I, Frame& F) {
    moe_scale_estimate(I, F);
    int s_in, s_out;
    { float sv[2][16]; float m0 = 0.f, m1 = 0.f;
#pragma unroll
      for (int j = 0; j < 16; ++j) { const size_t p = (size_t)(F.tid * 16 + j) * 4099u; sv[0][j] = I.awin[p % ((size_t)D * 6144)]; sv[1][j] = I.awout[p % ((size_t)D * D)]; }
#pragma unroll
      for (int j = 0; j < 16; ++j) { m0 = __builtin_fmaxf(m0, __builtin_fabsf(sv[0][j])); m1 = __builtin_fmaxf(m1, __builtin_fabsf(sv[1][j])); }
#pragma unroll
      for (int o = 1; o < 64; o <<= 1) { m0 = __builtin_fmaxf(m0, __shfl_xor(m0, o)); m1 = __builtin_fmaxf(m1, __shfl_xor(m1, o)); }
      LAS float* red = (LAS float*)(F.lds + RING_OFF);
      if (F.lane == 0) { red[F.wave] = m0; red[8 + F.wave] = m1; }
      __syncthreads();
#pragma unroll
      for (int w = 0; w < NWAVES; ++w) { m0 = __builtin_fmaxf(m0, red[w]); m1 = __builtin_fmaxf(m1, red[8 + w]); }
      __syncthreads();
      s_in = 0; if (m0 > 0.f && m0 < 3.0e38f) { s_in = (int)floorf(log2f(28.0f / m0)); s_in = s_in < -60 ? -60 : (s_in > 60 ? 60 : s_in); }
      s_out = 0; if (m1 > 0.f && m1 < 3.0e38f) { s_out = (int)floorf(log2f(28.0f / m1)); s_out = s_out < -60 ? -60 : (s_out > 60 ? 60 : s_out); } }
    if (blockIdx.x == 0 && F.tid == 0) { ((GAS int*)F.ctl)[CW_FSC + 4] = s_in; ((GAS int*)F.ctl)[CW_FSC + 5] = s_out; }
    const float m_in = __uint_as_float((unsigned)(127 + s_in) << 23), m_out = __uint_as_float((unsigned)(127 + s_out) << 23);
    LAS float* scr = (LAS float*)(F.lds + RING_OFF + F.wave * 16384);
    const int gw = F.vcu * NWAVES + F.wave, NGW = F.G * NWAVES;
    constexpr int I_AIN = 32 * 192, I_AOUT = 32 * 64;
    constexpr int NITEMS = I_AIN + I_AOUT;
    for (int it = gw; it < NITEMS; it += NGW) {
        int r = it;
        if (r < I_AIN) { const int kb = r / 192, nb = r % 192; tr_item8(I.awin, 6144, kb * 64, nb * 32, F.ws + WS_WAIN, D, nb * 32, scr, F.lane, m_in); continue; } r -= I_AIN;
        { const int kb = r / 64, nb = r % 64; tr_item8(I.awout, D, kb * 64, nb * 32, F.ws + WS_WAOUT, D, nb * 32, scr, F.lane, m_out); }
    }
    unsigned char* XF8 = F.ws + WS_A0;
    for (int m = gw; m < M; m += NGW) {
        const GAS f32x4* xr = (const GAS f32x4*)(I.x + (size_t)m * D);
#pragma unroll
        for (int j = 0; j < 2; ++j) { const int ch = F.lane + 64 * j; const f32x4 a = __builtin_nontemporal_load(xr + 4 * ch), b = __builtin_nontemporal_load(xr + 4 * ch + 1), c = __builtin_nontemporal_load(xr + 4 * ch + 2), d = __builtin_nontemporal_load(xr + 4 * ch + 3);
            v4u o; o.x = pk4_fp8(a.x, a.y, a.z, a.w); o.y = pk4_fp8(b.x, b.y, b.z, b.w); o.z = pk4_fp8(c.x, c.y, c.z, c.w); o.w = pk4_fp8(d.x, d.y, d.z, d.w); *(GAS v4u*)(XF8 + (size_t)m * D + 16 * ch) = o; }
    }
}
__device__ __forceinline__ void fp8x4_f32_(unsigned w, float* o) { const pg8::f32x2 lo = __builtin_amdgcn_cvt_pk_f32_fp8((int)w, false), hi = __builtin_amdgcn_cvt_pk_f32_fp8((int)w, true); o[0] = lo.x; o[1] = lo.y; o[2] = hi.x; o[3] = hi.y; }
__device__ __forceinline__ pg8::u32x4 widen8_bf16(unsigned lo, unsigned hi, float sc) {
    float f[8]; fp8x4_f32_(lo, f); fp8x4_f32_(hi, f + 4);
    pg8::u32x4 o; o.x = pg8::cvt_pk_bf16(f[0] * sc, f[1] * sc); o.y = pg8::cvt_pk_bf16(f[2] * sc, f[3] * sc); o.z = pg8::cvt_pk_bf16(f[4] * sc, f[5] * sc); o.w = pg8::cvt_pk_bf16(f[6] * sc, f[7] * sc); return o; }
struct EpiF8 {
    static constexpr bool PERM = true;
    unsigned char* O; int ldc; int split_cols; size_t split_stride; float s0, s1;
    __device__ __forceinline__ void operator()(const pg8::f32x4 (&acc)[2][2][4][2], const pg8::Unit& u, int wr, int wc, int fr, int fq) const {
        using namespace pg8;
        const int row0 = u.pm * BM + wr * 64 + fr; int colt = u.pn * BM; const int t = colt / split_cols; unsigned char* base = O + (size_t)t * split_stride; colt -= t * split_cols;
        const float sc = t == 0 ? s0 : s1; const int col0 = colt + wc * 32 + 8 * fq;
#pragma unroll
        for (int ai = 0; ai < 2; ++ai)
#pragma unroll
            for (int m = 0; m < 4; ++m) { unsigned char* rowp = base + (size_t)(row0 + ai * HALF + m * 16) * ldc + col0;
#pragma unroll
                for (int bj = 0; bj < 2; ++bj) { const f32x4 v0 = acc[ai][bj][m][0] * sc, v1 = acc[ai][bj][m][1] * sc;
                    u32x2 w; w.x = pk4_fp8(v0[0], v0[1], v0[2], v0[3]); w.y = pk4_fp8(v1[0], v1[1], v1[2], v1[3]); *(GAS u32x2*)(rowp + bj * HALF) = w; } }
    }
};
namespace natt {
constexpr float ATT_O_SCALE = 16.0f, ATT_V_SCALE = 4.0f, ATT_Q_SCALE = 0.08838834764831845f;
typedef short bf16x8 __attribute__((ext_vector_type(8)));
typedef float f32x4 __attribute__((ext_vector_type(4)));
typedef unsigned u32x2 __attribute__((ext_vector_type(2)));
typedef unsigned u32x4 __attribute__((ext_vector_type(4)));
constexpr int KROW = 272, VROW = 144, KBUF = 64 * KROW, VBUF = 128 * VROW, BUF = KBUF + VBUF, RPB_OFF = 2 * BUF, LDS_NEED = RPB_OFF + 2048;
constexpr float LOG2E = 1.4426950408889634f;
__device__ __forceinline__ int clampi(int v, int lo, int hi) { return v < lo ? lo : (v > hi ? hi : v); }
__device__ __forceinline__ void attn_phase(LAS unsigned char* lds, const unsigned char* Q, const unsigned char* Kg, const unsigned char* VTg, unsigned char* O, const float* rpb, int G, int vcu) {
    const int tid = threadIdx.x, lane = tid & 63, w = __builtin_amdgcn_readfirstlane(tid >> 6), g = lane >> 4, i = lane & 15;
    LAS float* rpbs = (LAS float*)(lds + RPB_OFF);
    for (int unit = vcu; unit < 2048; unit += G) {
        const int b = unit >> 8, h = (unit >> 4) & 15, rp = unit & 15;
        const int r_w = 2 * rp + (w >> 2), jq = w & 3, qc = 16 * jq + i, cw = clampi(16 * jq - 8, 0, 32);
        const int rs_w = clampi(r_w - 4, 0, 24), kr_lo = clampi(2 * rp - 4, 0, 24), kr_hi = clampi(2 * rp - 3, 0, 24) + 8, cs = clampi(qc - 8, 0, 48);
        const size_t tok0 = (size_t)b * 2048;
        bf16x8 qf[4];
        { const unsigned char* qp = Q + (tok0 + r_w * 64 + qc) * 2048 + h * 128 + 8 * g;
#pragma unroll
          for (int s = 0; s < 4; ++s) { const u32x2 qw = *(const GAS u32x2*)(qp + 32 * s); qf[s] = __builtin_bit_cast(bf16x8, widen8_bf16(qw.x, qw.y, ATT_Q_SCALE)); } }
        u32x4 kA, vA, kB, vB, kC, vC;
        const unsigned char* kbase = Kg + (tok0 + (tid >> 3)) * 2048 + h * 128 + (tid & 7) * 16;
        const unsigned char* vbase = VTg + ((size_t)b * 2048 + h * 128 + (tid >> 2)) * 2048 + (tid & 3) * 16;
#define NATT_LOAD(kreg, vreg, kr) do { kreg = *(const GAS u32x4*)(kbase + ((size_t)(kr) * 64) * 2048); vreg = *(const GAS u32x4*)(vbase + (kr) * 64); } while (0)
#define NATT_PUT(kreg, vreg, buf) do { LAS unsigned char* kd = (buf) + (tid >> 3) * KROW + (tid & 7) * 32; *(LAS u32x4*)kd = widen8_bf16(kreg.x, kreg.y, 1.0f); *(LAS u32x4*)(kd + 16) = widen8_bf16(kreg.z, kreg.w, 1.0f); \
            LAS unsigned char* vd = (buf) + KBUF + (tid >> 2) * VROW + (tid & 3) * 32; *(LAS u32x4*)vd = widen8_bf16(vreg.x, vreg.y, 1.0f); *(LAS u32x4*)(vd + 16) = widen8_bf16(vreg.z, vreg.w, 1.0f); } while (0)
        __syncthreads();
        if (tid < 465) rpbs[tid] = rpb[h * 465 + tid] * LOG2E;
        NATT_LOAD(kA, vA, kr_lo); NATT_LOAD(kB, vB, kr_lo + 1); NATT_LOAD(kC, vC, kr_lo + 2);
        f32x4 o[8];
#pragma unroll
        for (int dt = 0; dt < 8; ++dt) o[dt] = (f32x4){0.f, 0.f, 0.f, 0.f};
        float mrun = -1e30f, lrun = 0.f;
        int bofs[8];
#pragma unroll
        for (int kt = 0; kt < 2; ++kt)
#pragma unroll
            for (int j = 0; j < 4; ++j) { const int kc = cw + 16 * kt + 4 * g + j; bofs[kt * 4 + j] = ((kc >= cs) && (kc < cs + 16)) ? (kc - qc + 15) : -1; }
        int par = 0;
#define NATT_COMPUTE(kr, buf) do { if ((kr) >= rs_w && (kr) < rs_w + 8) { \
                const LAS unsigned char* kb = (buf) + (cw + i) * KROW + 16 * g; \
                f32x4 st[2]; \
                _Pragma("unroll") for (int kt = 0; kt < 2; ++kt) { st[kt] = (f32x4){0.f, 0.f, 0.f, 0.f}; \
                    _Pragma("unroll") for (int s = 0; s < 4; ++s) { const bf16x8 a = *(const LAS bf16x8*)(kb + kt * 16 * KROW + s * 64); st[kt] = __builtin_amdgcn_mfma_f32_16x16x32_bf16(a, qf[s], st[kt], 0, 0, 0); } } \
                const int dr = (kr) - r_w + 7; \
                float sc[8]; float mx = -1e30f; \
                _Pragma("unroll") for (int kt = 0; kt < 2; ++kt) \
                    _Pragma("unroll") for (int j = 0; j < 4; ++j) { const int bo = bofs[kt * 4 + j]; const float bias = rpbs[dr * 31 + (bo < 0 ? 0 : bo)]; \
                        const float v = bo >= 0 ? st[kt][j] * LOG2E + bias : -1e30f; sc[kt * 4 + j] = v; mx = fmaxf(mx, v); } \
                mx = fmaxf(mx, __shfl_xor(mx, 16)); mx = fmaxf(mx, __shfl_xor(mx, 32)); \
                const float mnew = fmaxf(mrun, mx), al = __builtin_amdgcn_exp2f(mrun - mnew); mrun = mnew; \
                float ps = 0.f; \
                _Pragma("unroll") for (int k = 0; k < 8; ++k) { sc[k] = __builtin_amdgcn_exp2f(sc[k] - mnew); ps += sc[k]; } \
                lrun = lrun * al + ps; \
                if (__builtin_amdgcn_ballot_w64(al != 1.0f) != 0ull) { _Pragma("unroll") for (int dt = 0; dt < 8; ++dt) o[dt] = o[dt] * al; } \
                u32x4 pw; pw.x = pg8::cvt_pk_bf16(sc[0], sc[1]); pw.y = pg8::cvt_pk_bf16(sc[2], sc[3]); pw.z = pg8::cvt_pk_bf16(sc[4], sc[5]); pw.w = pg8::cvt_pk_bf16(sc[6], sc[7]); \
                const bf16x8 pf = __builtin_bit_cast(bf16x8, pw); \
                const LAS unsigned char* vb = (buf) + KBUF + i * VROW + (cw + 4 * g) * 2; \
                _Pragma("unroll") for (int dt = 0; dt < 8; ++dt) { const u32x2 lo = *(const LAS u32x2*)(vb + dt * 16 * VROW), hi = *(const LAS u32x2*)(vb + dt * 16 * VROW + 32); \
                    u32x4 aw; aw.x = lo.x; aw.y = lo.y; aw.z = hi.x; aw.w = hi.y; \
                    o[dt] = __builtin_amdgcn_mfma_f32_16x16x32_bf16(__builtin_bit_cast(bf16x8, aw), pf, o[dt], 0, 0, 0); } } } while (0)
#define NATT_STEP(kreg, vreg, kr) do { if ((kr) < kr_hi) { LAS unsigned char* buf = lds + par * BUF; par ^= 1; \
                NATT_PUT(kreg, vreg, buf); asm volatile("s_waitcnt lgkmcnt(0)" ::: "memory"); __builtin_amdgcn_s_barrier(); asm volatile("" ::: "memory"); if ((kr) + 3 < kr_hi) NATT_LOAD(kreg, vreg, (kr) + 3); NATT_COMPUTE(kr, buf); } } while (0)
        for (int kr = kr_lo; kr < kr_hi; kr += 3) { NATT_STEP(kA, vA, kr); NATT_STEP(kB, vB, kr + 1); NATT_STEP(kC, vC, kr + 2); }
#undef NATT_STEP
#undef NATT_COMPUTE
#undef NATT_PUT
        float lt = lrun; lt += __shfl_xor(lt, 16); lt += __shfl_xor(lt, 32);
        const float inv = ATT_O_SCALE / (ATT_V_SCALE * lt);
        unsigned char* op = O + (tok0 + r_w * 64 + qc) * 2048 + h * 128 + 4 * g;
#pragma unroll
        for (int dt = 0; dt < 8; ++dt) *(GAS unsigned*)(op + 16 * dt) = pk4_fp8(o[dt][0] * inv, o[dt][1] * inv, o[dt][2] * inv, o[dt][3] * inv);
#undef NATT_LOAD
    }
}
}

template <bool RES_BF16> struct EpiResStats {
    static constexpr bool PERM = true;
    const void* res; unsigned short* Y; float* part; float gs = 1.f;
    __device__ __forceinline__ void operator()(const pg8::f32x4 (&acc)[2][2][4][2], const pg8::Unit& u, int wr, int wc, int fr, int fq) const {
        using namespace pg8;
        const int row0 = u.pm * BM + wr * 64 + fr, col0 = u.pn * BM + wc * 32 + 8 * fq;
        float s1[2][4], s2[2][4];
#pragma unroll
        for (int ai = 0; ai < 2; ++ai) {
            u32x4 rb[4][2]; f32x4 rf[4][2][2];
#pragma unroll
            for (int m = 0; m < 4; ++m) { const size_t off = (size_t)(row0 + ai * HALF + m * 16) * D + col0;
#pragma unroll
                for (int bj = 0; bj < 2; ++bj) {
                    if (RES_BF16) rb[m][bj] = *(const GAS u32x4*)((const unsigned short*)res + off + bj * HALF);
                    else { rf[m][bj][0] = __builtin_nontemporal_load((const GAS f32x4*)((const float*)res + off + bj * HALF)); rf[m][bj][1] = __builtin_nontemporal_load((const GAS f32x4*)((const float*)res + off + bj * HALF + 4)); } } }
            __builtin_amdgcn_sched_barrier(0);
#pragma unroll
            for (int m = 0; m < 4; ++m) { const size_t off = (size_t)(row0 + ai * HALF + m * 16) * D + col0; float t1 = 0.f, t2 = 0.f;
#pragma unroll
                for (int bj = 0; bj < 2; ++bj) { float r[8];
                    if (RES_BF16) { const u32x4 rw = rb[m][bj];
                        r[0] = bf_lo(rw.x); r[1] = bf_hi(rw.x); r[2] = bf_lo(rw.y); r[3] = bf_hi(rw.y); r[4] = bf_lo(rw.z); r[5] = bf_hi(rw.z); r[6] = bf_lo(rw.w); r[7] = bf_hi(rw.w); }
                    else { const f32x4 a = rf[m][bj][0], b = rf[m][bj][1];
                        r[0] = a.x; r[1] = a.y; r[2] = a.z; r[3] = a.w; r[4] = b.x; r[5] = b.y; r[6] = b.z; r[7] = b.w; }
                    const f32x4 v0 = acc[ai][bj][m][0] * gs, v1 = acc[ai][bj][m][1] * gs;
                    u32x4 w; w.x = cvt_pk_bf16(ALPHA * r[0] + v0[0], ALPHA * r[1] + v0[1]); w.y = cvt_pk_bf16(ALPHA * r[2] + v0[2], ALPHA * r[3] + v0[3]);
                    w.z = cvt_pk_bf16(ALPHA * r[4] + v1[0], ALPHA * r[5] + v1[1]); w.w = cvt_pk_bf16(ALPHA * r[6] + v1[2], ALPHA * r[7] + v1[3]);
                    *(GAS u32x4*)(Y + off + bj * HALF) = w;
                    const float q0 = bf_lo(w.x), q1 = bf_hi(w.x), q2 = bf_lo(w.y), q3 = bf_hi(w.y), q4 = bf_lo(w.z), q5 = bf_hi(w.z), q6 = bf_lo(w.w), q7 = bf_hi(w.w);
                    t1 += ((q0 + q1) + (q2 + q3)) + ((q4 + q5) + (q6 + q7));
                    t2 += ((q0 * q0 + q1 * q1) + (q2 * q2 + q3 * q3)) + ((q4 * q4 + q5 * q5) + (q6 * q6 + q7 * q7)); }
                t1 += __shfl_xor(t1, 16); t1 += __shfl_xor(t1, 32); t2 += __shfl_xor(t2, 16); t2 += __shfl_xor(t2, 32);
                s1[ai][m] = t1; s2[ai][m] = t2; }
        }
#pragma unroll
        for (int ai = 0; ai < 2; ++ai) {
            const float v1 = fq == 0 ? s1[ai][0] : (fq == 1 ? s1[ai][1] : (fq == 2 ? s1[ai][2] : s1[ai][3]));
            const float v2 = fq == 0 ? s2[ai][0] : (fq == 1 ? s2[ai][1] : (fq == 2 ? s2[ai][2] : s2[ai][3]));
            const int row = u.pm * BM + ai * HALF + wr * 64 + 16 * fq + fr;
            f32x2 pv; pv.x = v1; pv.y = v2;
            *(GAS f32x2*)(part + ((size_t)(u.pn * 4 + wc) * M + row) * 2) = pv;
        }
    }
};
constexpr size_t WRF_LAYER_BYTES = (size_t)64 * 3 * 2 * 64 * 16;
constexpr size_t WS_WRF = WS_TAB + 2 * MiB;
constexpr size_t WS_LIST = WS_MISC, WS_ROUTEW = WS_MISC + 2 * MiB, WS_PART = WS_MISC + 3 * MiB;
constexpr int LN_LG_STRIDE = 49;

__device__ __forceinline__ void build_router_frags(const Ins& I, Frame& F) {
    for (int idx = (F.vcu * NWAVES + F.wave) * 64 + F.lane; idx < 2 * 64 * 3 * 64; idx += F.G * NWAVES * 64) {
        const int lane = idx & 63, nt = (idx >> 6) % 3, s = (idx / 192) & 63, layer = idx / (192 * 64);
        const int g = lane >> 4, i = lane & 15, c = 16 * nt + i;
        float w[8];
#pragma unroll
        for (int j = 0; j < 8; ++j) { const int k = 32 * s + 8 * g + j;
            w[j] = c < 4 ? I.wgr[(size_t)layer * D * 4 + k * 4 + c] : (c < 36 ? I.wer[(size_t)layer * D * 32 + k * 32 + (c - 4)] : 0.f); }
        v4u hi, lo;
        hi.x = pk2(w[0], w[1]); hi.y = pk2(w[2], w[3]); hi.z = pk2(w[4], w[5]); hi.w = pk2(w[6], w[7]);
        lo.x = pk2(w[0] - pg8::bf_lo(hi.x), w[1] - pg8::bf_hi(hi.x)); lo.y = pk2(w[2] - pg8::bf_lo(hi.y), w[3] - pg8::bf_hi(hi.y));
        lo.z = pk2(w[4] - pg8::bf_lo(hi.z), w[5] - pg8::bf_hi(hi.z)); lo.w = pk2(w[6] - pg8::bf_lo(hi.w), w[7] - pg8::bf_hi(hi.w));
        GAS v4u* dst = (GAS v4u*)(F.ws + WS_WRF + (size_t)layer * WRF_LAYER_BYTES) + ((size_t)(s * 3 + nt) * 2) * 64 + lane;
        dst[0] = hi; dst[64] = lo;
    }
}

constexpr int LN_PL_OFF = 16384, LN_PL_WAVE = 32 * 48 * 4, LN_FL_OFF = LN_PL_OFF + 8 * LN_PL_WAVE;
__device__ __forceinline__ void ln_router_phase(Frame& F, const bf16* Y, const float* part, const float* gain, const float* bias, bf16* X1, unsigned char* XF8,
                                                const unsigned char* wrf, const float* bgr, const float* ber, unsigned* cnt, int* list, float* routew, bool do_route) {
    typedef short bf16x8 __attribute__((ext_vector_type(8))); typedef float f32x2 __attribute__((ext_vector_type(2)));
    LAS float* gl = (LAS float*)(F.lds); LAS float* bl = gl + D;
    for (int c = F.tid; c < D; c += NWAVES * 64) { gl[c] = gain[c]; bl[c] = bias[c]; }
    __syncthreads();
    LAS float* pl = (LAS float*)(F.lds + LN_PL_OFF + F.wave * LN_PL_WAVE);
    LAS float* fl = (LAS float*)(F.lds + LN_FL_OFF);
    const int lane = F.lane, g = lane >> 4, i = lane & 15;
    for (int task = F.vcu; task < M / 32; task += F.G) {
        const int row0 = task * 32;
        float mean[2], rstd[2];
#pragma unroll
        for (int rb = 0; rb < 2; ++rb) { const int row = row0 + 16 * rb + i; float s1 = 0.f, s2 = 0.f;
#pragma unroll
            for (int q = 0; q < 8; ++q) { const f32x2 pv = *(const GAS f32x2*)(part + ((size_t)(8 * g + q) * M + row) * 2); s1 += pv.x; s2 += pv.y; }
            s1 += __shfl_xor(s1, 16); s1 += __shfl_xor(s1, 32); s2 += __shfl_xor(s2, 16); s2 += __shfl_xor(s2, 32);
            const float mu = s1 * (1.f / D); const float var = s2 * (1.f / D) - mu * mu; mean[rb] = mu; rstd[rb] = rsqrtf(fmaxf(var, 0.f) + LN_EPS); }
        f32x4 acc[2][3];
#pragma unroll
        for (int rb = 0; rb < 2; ++rb)
#pragma unroll
            for (int nt = 0; nt < 3; ++nt) acc[rb][nt] = (f32x4){0.f, 0.f, 0.f, 0.f};
        const GAS v4u* wf = (const GAS v4u*)wrf + lane;
#pragma unroll 2
        for (int ss = 0; ss < 8; ++ss) {
            const int s = F.wave * 8 + ss, k0 = 32 * s + 8 * g;
            const f32x4 g0 = *(const LAS f32x4*)(gl + k0), g1 = *(const LAS f32x4*)(gl + k0 + 4), b0 = *(const LAS f32x4*)(bl + k0), b1 = *(const LAS f32x4*)(bl + k0 + 4);
            v4u bh[3], blo[3];
#pragma unroll
            for (int nt = 0; nt < 3; ++nt) { bh[nt] = wf[(size_t)((s * 3 + nt) * 2) * 64]; blo[nt] = wf[(size_t)((s * 3 + nt) * 2 + 1) * 64]; }
#pragma unroll
            for (int rb = 0; rb < 2; ++rb) {
                const size_t off = (size_t)(row0 + 16 * rb + i) * D + k0;
                const v4u yw = *(const GAS v4u*)(Y + off);
                const float mu = mean[rb], rs = rstd[rb];
                float x[8];
                x[0] = (pg8::bf_lo(yw.x) - mu) * rs * g0.x + b0.x; x[1] = (pg8::bf_hi(yw.x) - mu) * rs * g0.y + b0.y; x[2] = (pg8::bf_lo(yw.y) - mu) * rs * g0.z + b0.z; x[3] = (pg8::bf_hi(yw.y) - mu) * rs * g0.w + b0.w;
                x[4] = (pg8::bf_lo(yw.z) - mu) * rs * g1.x + b1.x; x[5] = (pg8::bf_hi(yw.z) - mu) * rs * g1.y + b1.y; x[6] = (pg8::bf_lo(yw.w) - mu) * rs * g1.z + b1.z; x[7] = (pg8::bf_hi(yw.w) - mu) * rs * g1.w + b1.w;
                v4u hi, lo;
                hi.x = pk2(x[0], x[1]); hi.y = pk2(x[2], x[3]); hi.z = pk2(x[4], x[5]); hi.w = pk2(x[6], x[7]);
                { pg8::u32x2 f8; f8.x = pk4_fp8(x[0], x[1], x[2], x[3]); f8.y = pk4_fp8(x[4], x[5], x[6], x[7]); *(GAS pg8::u32x2*)(XF8 + off) = f8; }
                lo.x = pk2(x[0] - pg8::bf_lo(hi.x), x[1] - pg8::bf_hi(hi.x)); lo.y = pk2(x[2] - pg8::bf_lo(hi.y), x[3] - pg8::bf_hi(hi.y));
                lo.z = pk2(x[4] - pg8::bf_lo(hi.z), x[5] - pg8::bf_hi(hi.z)); lo.w = pk2(x[6] - pg8::bf_lo(hi.w), x[7] - pg8::bf_hi(hi.w));
                const bf16x8 ah = __builtin_bit_cast(bf16x8, hi), al = __builtin_bit_cast(bf16x8, lo);
#pragma unroll
                for (int nt = 0; nt < 3; ++nt) {
                    acc[rb][nt] = __builtin_amdgcn_mfma_f32_16x16x32_bf16(ah, __builtin_bit_cast(bf16x8, bh[nt]), acc[rb][nt], 0, 0, 0);
                    acc[rb][nt] = __builtin_amdgcn_mfma_f32_16x16x32_bf16(al, __builtin_bit_cast(bf16x8, bh[nt]), acc[rb][nt], 0, 0, 0);
                    acc[rb][nt] = __builtin_amdgcn_mfma_f32_16x16x32_bf16(ah, __builtin_bit_cast(bf16x8, blo[nt]), acc[rb][nt], 0, 0, 0);
                }
            }
        }
#pragma unroll
        for (int rb = 0; rb < 2; ++rb)
#pragma unroll
            for (int nt = 0; nt < 3; ++nt)
#pragma unroll
                for (int j = 0; j < 4; ++j) pl[(16 * rb + 4 * g + j) * 48 + 16 * nt + i] = acc[rb][nt][j];
        __syncthreads();
        { const int row = F.tid >> 4, c = F.tid & 15;
#pragma unroll
          for (int nt = 0; nt < 3; ++nt) { float sum = 0.f;
#pragma unroll
              for (int w = 0; w < 8; ++w) sum += *(const LAS float*)(F.lds + LN_PL_OFF + w * LN_PL_WAVE + (row * 48 + 16 * nt + c) * 4);
              fl[row * LN_LG_STRIDE + 16 * nt + c] = sum; } }
        __syncthreads();
        if (F.tid < 32 && do_route) {
            const LAS float* lr = fl + F.tid * LN_LG_STRIDE; const int row = row0 + F.tid;
            float gv[4];
#pragma unroll
            for (int q = 0; q < 4; ++q) gv[q] = lr[q] + bgr[q];
            int gs = 0; float gm = gv[0];
#pragma unroll
            for (int q = 1; q < 4; ++q) if (gv[q] > gm) { gm = gv[q]; gs = q; }
            float den = 0.f;
#pragma unroll
            for (int q = 0; q < 4; ++q) den += __expf(gv[q] - gm);
            const float wg = 1.f / den;
            float ev[8];
#pragma unroll
            for (int q = 0; q < 8; ++q) ev[q] = lr[4 + gs * 8 + q] + ber[gs * 8 + q];
            int e1 = 0; float v1 = ev[0];
#pragma unroll
            for (int q = 1; q < 8; ++q) if (ev[q] > v1) { v1 = ev[q]; e1 = q; }
            int e2 = -1; float v2 = -3.0e38f;
#pragma unroll
            for (int q = 0; q < 8; ++q) if (q != e1 && ev[q] > v2) { v2 = ev[q]; e2 = q; }
            const float a1 = 1.f / (1.f + __expf(v2 - v1));
            const int E0 = gs * 8 + e1, E1 = gs * 8 + e2;
            const unsigned p0 = __hip_atomic_fetch_add(cnt + 64 * E0, 1u, __ATOMIC_RELAXED, __HIP_MEMORY_SCOPE_AGENT);
            const unsigned p1 = __hip_atomic_fetch_add(cnt + 64 * E1, 1u, __ATOMIC_RELAXED, __HIP_MEMORY_SCOPE_AGENT);
            list[(size_t)E0 * M + p0] = row * 2; list[(size_t)E1 * M + p1] = row * 2 + 1;
            routew[row * 2] = a1 * wg; routew[row * 2 + 1] = (1.f - a1) * wg;
        }
        __syncthreads();
    }
}

template <bool GATHER_> struct MoeOrder {
    static constexpr bool GATHER = GATHER_, CARRY = false; static constexpr int MODE = 1;
    const LAS int* tab; const unsigned* cnt; const int* list; const char* A; const char* B; size_t tA, bE, tB; int nN, G, c;
    int lo, hi;
    int n_busy, head;
    __device__ __forceinline__ bool next(int i, pg8::Unit& u) const {
        const int n_idle = G - n_busy; int L;
        if (c >= n_busy) { const int j = c - n_busy; L = (i < head) ? i * n_idle + j : head * n_idle + (i - head) * G + j; }
        else L = head * n_idle + i * G + n_idle + c;
        L += lo; if (L >= hi) return false;
        const int t = L / nN; int E = 0;
        for (int e = 1; e < 32; ++e) E = (tab[e] <= t) ? e : E;
        u.pm = t; u.pn = L % nN; u.z = E; u.aux = t - tab[E]; return true;
    }
    __device__ __forceinline__ const char* abase(const pg8::Unit& u) const { return GATHER ? A : A + (size_t)u.pm * tA; }
    __device__ __forceinline__ const char* bbase(const pg8::Unit& u) const { return B + (size_t)u.z * bE + (size_t)u.pn * tB; }
    __device__ __forceinline__ unsigned arow(const pg8::Unit& u, int r) const {
        if (!GATHER) return (unsigned)r;
        const unsigned pos = (unsigned)(u.aux * 256 + r); const unsigned n = cnt[64 * u.z];
        return pos < n ? (unsigned)(list[(size_t)u.z * M + pos] >> 1) : 0u;
    }
    __device__ __forceinline__ void a_ready(const pg8::Unit&) const {}
    __device__ __forceinline__ void done(const pg8::Unit&) const {}
};
__device__ __forceinline__ void moe_build_table(Frame& F, LAS int* tab, const unsigned* cnt) {
    if (F.tid == 0) { int acc = 0; for (int e = 0; e < 32; ++e) { tab[e] = acc; acc += (int)((cnt[64 * e] + 255u) >> 8); } tab[32] = acc; }
    __syncthreads();
}
struct EpiSwiGLU {
    static constexpr bool PERM = true;
    unsigned char* H; float inv;
    __device__ __forceinline__ void operator()(const pg8::f32x4 (&acc)[2][2][4][2], const pg8::Unit& u, int wr, int wc, int fr, int fq) const {
        using namespace pg8;
        const int row0 = u.pm * BM + wr * 64 + fr, col0 = u.pn * 128 + wc * 32 + 8 * fq;
#pragma unroll
        for (int ai = 0; ai < 2; ++ai)
#pragma unroll
            for (int m = 0; m < 4; ++m) { const f32x4 g0 = acc[ai][0][m][0] * inv, g1 = acc[ai][0][m][1] * inv, u0 = acc[ai][1][m][0] * inv, u1 = acc[ai][1][m][1] * inv;
                u32x2 w; w.x = pk4_fp8(silu_f(g0[0]) * u0[0], silu_f(g0[1]) * u0[1], silu_f(g0[2]) * u0[2], silu_f(g0[3]) * u0[3]);
                w.y = pk4_fp8(silu_f(g1[0]) * u1[0], silu_f(g1[1]) * u1[1], silu_f(g1[2]) * u1[2], silu_f(g1[3]) * u1[3]);
                *(GAS u32x2*)(H + (size_t)(row0 + ai * HALF + m * 16) * FF + col0) = w; }
    }
};
constexpr float O_SCALE = 16.0f;
__device__ __forceinline__ void fp8x4_f32(unsigned w, float* o) { const pg8::f32x2 lo = __builtin_amdgcn_cvt_pk_f32_fp8((int)w, false), hi = __builtin_amdgcn_cvt_pk_f32_fp8((int)w, true); o[0] = lo.x; o[1] = lo.y; o[2] = hi.x; o[3] = hi.y; }
struct EpiScatter {
    static constexpr bool PERM = true;
    const unsigned* cnt; const int* list; unsigned char* O01; float inv;
    __device__ __forceinline__ void operator()(const pg8::f32x4 (&acc)[2][2][4][2], const pg8::Unit& u, int wr, int wc, int fr, int fq) const {
        using namespace pg8;
        const unsigned n = cnt[64 * u.z]; const int col0 = u.pn * BM + wc * 32 + 8 * fq;
        int tks[2][4];
#pragma unroll
        for (int ai = 0; ai < 2; ++ai)
#pragma unroll
            for (int m = 0; m < 4; ++m) { const unsigned pos = (unsigned)(u.aux * 256 + ai * HALF + wr * 64 + m * 16 + fr); tks[ai][m] = pos < n ? list[(size_t)u.z * M + pos] : -1; }
        __builtin_amdgcn_sched_barrier(0);
#pragma unroll
        for (int ai = 0; ai < 2; ++ai)
#pragma unroll
            for (int m = 0; m < 4; ++m) { const int tk = tks[ai][m];
                if (tk >= 0) { unsigned char* dst = O01 + ((size_t)(tk & 1) * M + (size_t)(tk >> 1)) * D + col0;
#pragma unroll
                    for (int bj = 0; bj < 2; ++bj) { const f32x4 v0 = acc[ai][bj][m][0] * inv, v1 = acc[ai][bj][m][1] * inv;
                        u32x2 w; w.x = pk4_fp8(v0[0], v0[1], v0[2], v0[3]); w.y = pk4_fp8(v1[0], v1[1], v1[2], v1[3]);
                        *(GAS u32x2*)(dst + bj * HALF) = w; } } }
    }
};

template <bool FINAL> __device__ __forceinline__ void combine_ln_phase(Frame& F, const bf16* Y, const float* part, const float* gA, const float* bA, const unsigned char* O01, const float* routew, const float* gain, const float* bias, bf16* outb, float* outf, unsigned char* out8 = nullptr, float* sx = nullptr) {
    const int gw = F.vcu * NWAVES + F.wave, NGW = F.G * NWAVES;
    for (int row = gw; row < M; row += NGW) {
        const float w0 = routew[row * 2] * (1.f / O_SCALE), w1 = routew[row * 2 + 1] * (1.f / O_SCALE);
        float mu1, rs1;
        { pg8::f32x2 pv; pv.x = 0.f; pv.y = 0.f; if (F.lane < 32) pv = *(const GAS pg8::f32x2*)(part + ((size_t)F.lane * M + row) * 2);
          const float t1 = wave_sum(pv.x), t2 = wave_sum(pv.y); mu1 = t1 * (1.f / D); const float var = t2 * (1.f / D) - mu1 * mu1; rs1 = rsqrtf(fmaxf(var, 0.f) + LN_EPS); }
        float v[4][8]; float s = 0.f;
#pragma unroll
        for (int j = 0; j < 4; ++j) { const size_t off = (size_t)row * D + 8 * (F.lane + 64 * j);
            const v4u yw = __builtin_nontemporal_load((const GAS v4u*)(Y + off));
            const pg8::u32x2 aw = __builtin_nontemporal_load((const GAS pg8::u32x2*)(O01 + off)), bw = __builtin_nontemporal_load((const GAS pg8::u32x2*)(O01 + (size_t)M * D + off));
            const int colA = 8 * (F.lane + 64 * j);
            const f32x4 ga0 = *(const GAS f32x4*)(gA + colA), ga1 = *(const GAS f32x4*)(gA + colA + 4), ba0 = *(const GAS f32x4*)(bA + colA), ba1 = *(const GAS f32x4*)(bA + colA + 4);
            float a[8], b[8]; fp8x4_f32(aw.x, a); fp8x4_f32(aw.y, a + 4); fp8x4_f32(bw.x, b); fp8x4_f32(bw.y, b + 4);
            float x[8];
            x[0] = (pg8::bf_lo(yw.x) - mu1) * rs1 * ga0.x + ba0.x; x[1] = (pg8::bf_hi(yw.x) - mu1) * rs1 * ga0.y + ba0.y; x[2] = (pg8::bf_lo(yw.y) - mu1) * rs1 * ga0.z + ba0.z; x[3] = (pg8::bf_hi(yw.y) - mu1) * rs1 * ga0.w + ba0.w;
            x[4] = (pg8::bf_lo(yw.z) - mu1) * rs1 * ga1.x + ba1.x; x[5] = (pg8::bf_hi(yw.z) - mu1) * rs1 * ga1.y + ba1.y; x[6] = (pg8::bf_lo(yw.w) - mu1) * rs1 * ga1.z + ba1.z; x[7] = (pg8::bf_hi(yw.w) - mu1) * rs1 * ga1.w + ba1.w;
#pragma unroll
            for (int e = 0; e < 8; ++e) v[j][e] = ALPHA * x[e] + w0 * a[e] + w1 * b[e];
#pragma unroll
            for (int e = 0; e < 8; ++e) s += v[j][e]; }
        const float mean = wave_sum(s) * (1.f / D); float q = 0.f;
#pragma unroll
        for (int j = 0; j < 4; ++j)
#pragma unroll
            for (int e = 0; e < 8; ++e) { v[j][e] -= mean; q += v[j][e] * v[j][e]; }
        const float rstd = rsqrtf(wave_sum(q) * (1.f / D) + LN_EPS);
#pragma unroll
        for (int j = 0; j < 4; ++j) { const int col = 8 * (F.lane + 64 * j); const size_t off = (size_t)row * D + col;
            const f32x4 g0 = *(const GAS f32x4*)(gain + col), g1 = *(const GAS f32x4*)(gain + col + 4), b0 = *(const GAS f32x4*)(bias + col), b1 = *(const GAS f32x4*)(bias + col + 4);
            f32x4 o0, o1;
            o0.x = v[j][0] * rstd * g0.x + b0.x; o0.y = v[j][1] * rstd * g0.y + b0.y; o0.z = v[j][2] * rstd * g0.z + b0.z; o0.w = v[j][3] * rstd * g0.w + b0.w;
            o1.x = v[j][4] * rstd * g1.x + b1.x; o1.y = v[j][5] * rstd * g1.y + b1.y; o1.z = v[j][6] * rstd * g1.z + b1.z; o1.w = v[j][7] * rstd * g1.w + b1.w;
            if (FINAL) { __builtin_nontemporal_store(o0, (GAS f32x4*)(outf + off)); __builtin_nontemporal_store(o1, (GAS f32x4*)(outf + off + 4)); }
            else { v4u w; w.x = pk2(o0.x, o0.y); w.y = pk2(o0.z, o0.w); w.z = pk2(o1.x, o1.y); w.w = pk2(o1.z, o1.w); *(GAS v4u*)(outb + off) = w;
                v[j][0] = o0.x; v[j][1] = o0.y; v[j][2] = o0.z; v[j][3] = o0.w; v[j][4] = o1.x; v[j][5] = o1.y; v[j][6] = o1.z; v[j][7] = o1.w; } }
        if (!FINAL) {
            float mx = 0.f;
#pragma unroll
            for (int j = 0; j < 4; ++j)
#pragma unroll
                for (int e = 0; e < 8; ++e) mx = __builtin_fmaxf(mx, __builtin_fabsf(v[j][e]));
#pragma unroll
            for (int o = 1; o < 64; o <<= 1) mx = __builtin_fmaxf(mx, __shfl_xor(mx, o));
            const float sc = mx > 0.f ? mx * (1.f / 127.f) : 1.f, inv = 1.f / sc;
            if (F.lane == 0) sx[row] = sc;
#pragma unroll
            for (int j = 0; j < 4; ++j) { pg8::u32x2 w8; w8.x = pk4_i8(v[j][0] * inv, v[j][1] * inv, v[j][2] * inv, v[j][3] * inv); w8.y = pk4_i8(v[j][4] * inv, v[j][5] * inv, v[j][6] * inv, v[j][7] * inv);
                *(GAS pg8::u32x2*)(out8 + (size_t)row * D + 8 * (F.lane + 64 * j)) = w8; }
        }
    }
}
constexpr size_t WS_DECAY = WS_TAB + 3 * MiB;
__device__ __forceinline__ void build_decay_table(const Ins& I, Frame& F) {
    if (blockIdx.x == 0 && F.tid < 16) { const int h = F.tid >> 1, d = F.tid & 1; const float v = (d ? I.dbw : I.dfw)[h];
        ((float*)(F.ws + WS_DECAY))[F.tid] = log1pf(-expf(v)) * 1.4426950408889634f; }
}
struct EpiRetProj {
    static constexpr bool PERM = true;
    unsigned short *Q2, *K2, *G; const float *tcos, *tsin;
    __device__ __forceinline__ void operator()(const pg8::f32x4 (&acc)[2][2][4][2], const pg8::Unit& u, int wr, int wc, int fr, int fq) const {
        using namespace pg8;
        const int row0 = u.pm * BM + wr * 64 + fr, i0 = wc * 32 + 8 * fq;
        if (u.pn >= 16) {
            const int col0 = (u.pn - 16) * BM + i0;
#pragma unroll
            for (int ai = 0; ai < 2; ++ai)
#pragma unroll
                for (int m = 0; m < 4; ++m) { unsigned short* rowp = G + (size_t)(row0 + ai * HALF + m * 16) * RVW + col0;
#pragma unroll
                    for (int bj = 0; bj < 2; ++bj) { const f32x4 v0 = acc[ai][bj][m][0], v1 = acc[ai][bj][m][1];
                        u32x4 w; w.x = cvt_pk_bf16(silu_f(v0[0]), silu_f(v0[1])); w.y = cvt_pk_bf16(silu_f(v0[2]), silu_f(v0[3])); w.z = cvt_pk_bf16(silu_f(v1[0]), silu_f(v1[1])); w.w = cvt_pk_bf16(silu_f(v1[2]), silu_f(v1[3]));
                        __builtin_nontemporal_store(w, (GAS u32x4*)(rowp + bj * HALF));
#ifdef EXP_DOUBLE_STORE
                        *(GAS u32x4*)(rowp + bj * HALF + (size_t)(WS_A6 - WS_A5) / 2) = w;
#endif
                        } }
        } else {
            const int h = u.pn & 7; const bool isk = u.pn >= 8; unsigned short* base = isk ? K2 : Q2; const float sc = isk ? 0.0625f : 1.0f;
#pragma unroll
            for (int ai = 0; ai < 2; ++ai)
#pragma unroll
                for (int m = 0; m < 4; ++m) { const int tok = row0 + ai * HALF + m * 16, b = tok >> 11, s = tok & 2047;
                    const f32x4 c0 = *(const GAS f32x4*)(tcos + s * 128 + i0), c1 = *(const GAS f32x4*)(tcos + s * 128 + i0 + 4), s0 = *(const GAS f32x4*)(tsin + s * 128 + i0), s1 = *(const GAS f32x4*)(tsin + s * 128 + i0 + 4);
                    const f32x4 a0 = acc[ai][0][m][0], a1 = acc[ai][0][m][1], b0 = acc[ai][1][m][0], b1 = acc[ai][1][m][1];
                    const f32x4 o10 = (a0 * c0 - b0 * s0) * sc, o11 = (a1 * c1 - b1 * s1) * sc, o20 = (a0 * s0 + b0 * c0) * sc, o21 = (a1 * s1 + b1 * c1) * sc;
                    unsigned short* dst = base + ((size_t)(b * RH + h) * SEQ + s) * RQK + i0;
                    u32x4 w1, w2; w1.x = cvt_pk_bf16(o10[0], o10[1]); w1.y = cvt_pk_bf16(o10[2], o10[3]); w1.z = cvt_pk_bf16(o11[0], o11[1]); w1.w = cvt_pk_bf16(o11[2], o11[3]);
                    w2.x = cvt_pk_bf16(o20[0], o20[1]); w2.y = cvt_pk_bf16(o20[2], o20[3]); w2.z = cvt_pk_bf16(o21[0], o21[1]); w2.w = cvt_pk_bf16(o21[2], o21[3]);
                    *(GAS u32x4*)dst = w1; *(GAS u32x4*)(dst + 128) = w2; }
        }
    }
};
struct EpiDecay {
    static constexpr bool PERM = true;
    unsigned short* P; const float* lg2;
    __device__ __forceinline__ void operator()(const pg8::f32x4 (&acc)[2][2][4][2], const pg8::Unit& u, int wr, int wc, int fr, int fq) const {
        using namespace pg8;
        const int h = u.z & 7; const float lf = lg2[2 * h], lb = lg2[2 * h + 1];
        int r0 = wr * 64 + fr, c0 = wc * 32 + 8 * fq;
        asm volatile("" : "+v"(r0), "+v"(c0));
        unsigned short* base = P + (size_t)u.z * SEQ * SEQ + (size_t)(u.pm * BM) * SEQ + u.pn * BM;
        if (u.pm != u.pn) {
            const bool lower = u.pm > u.pn; const float lg = lower ? lf : lb;
            const int dp = 256 * (lower ? u.pm - u.pn : u.pn - u.pm);
#pragma unroll
            for (int bj = 0; bj < 2; ++bj) {
                float colf[8];
#pragma unroll
                for (int k = 0; k < 8; ++k) { const int c = c0 + bj * HALF + k; colf[k] = __builtin_amdgcn_exp2f(lg * (float)(lower ? dp - c : c)); }
#pragma unroll
                for (int ai = 0; ai < 2; ++ai)
#pragma unroll
                    for (int m = 0; m < 4; ++m) { const int r = r0 + ai * HALF + m * 16; const float rf = __builtin_amdgcn_exp2f(lg * (float)(lower ? r : dp - r));
                        const f32x4 v0 = acc[ai][bj][m][0], v1 = acc[ai][bj][m][1];
                        u32x4 w; w.x = cvt_pk_bf16(v0[0] * rf * colf[0], v0[1] * rf * colf[1]); w.y = cvt_pk_bf16(v0[2] * rf * colf[2], v0[3] * rf * colf[3]);
                        w.z = cvt_pk_bf16(v1[0] * rf * colf[4], v1[1] * rf * colf[5]); w.w = cvt_pk_bf16(v1[2] * rf * colf[6], v1[3] * rf * colf[7]);
                        *(GAS u32x4*)(base + (size_t)r * SEQ + c0 + bj * HALF) = w; __builtin_amdgcn_sched_barrier(0); }
                asm volatile("" ::: "memory");
            }
        } else {
#pragma unroll
            for (int ai = 0; ai < 2; ++ai)
#pragma unroll
                for (int m = 0; m < 4; ++m) { const int r = r0 + ai * HALF + m * 16; unsigned short* rowp = base + (size_t)r * SEQ + c0;
#pragma unroll
                    for (int bj = 0; bj < 2; ++bj) { float f[8];
#pragma unroll
                        for (int k = 0; k < 8; ++k) { const int d = r - (c0 + bj * HALF + k); f[k] = __builtin_amdgcn_exp2f(d >= 0 ? lf * (float)d : lb * (float)(-d)); }
                        const f32x4 v0 = acc[ai][bj][m][0], v1 = acc[ai][bj][m][1];
                        u32x4 w; w.x = cvt_pk_bf16(v0[0] * f[0], v0[1] * f[1]); w.y = cvt_pk_bf16(v0[2] * f[2], v0[3] * f[3]); w.z = cvt_pk_bf16(v1[0] * f[4], v1[1] * f[5]); w.w = cvt_pk_bf16(v1[2] * f[6], v1[3] * f[7]);
                        *(GAS u32x4*)(rowp + bj * HALF) = w; __builtin_amdgcn_sched_barrier(0); } }
        }
    }
};
struct EpiRetOut {
    static constexpr bool PERM = true;
    unsigned short* Y; int b0;
    __device__ __forceinline__ void operator()(const pg8::f32x4 (&acc)[2][2][4][2], const pg8::Unit& u, int wr, int wc, int fr, int fq) const {
        using namespace pg8;
        const int b = b0 + (u.z >> 3), h = u.z & 7;
        unsigned short* base = Y + ((size_t)b * SEQ + u.pm * BM + wr * 64 + fr) * RVW + h * RV + u.pn * BM + wc * 32 + 8 * fq;
#pragma unroll
        for (int ai = 0; ai < 2; ++ai)
#pragma unroll
            for (int m = 0; m < 4; ++m) { unsigned short* rowp = base + (size_t)(ai * HALF + m * 16) * RVW;
#pragma unroll
                for (int bj = 0; bj < 2; ++bj) { const f32x4 v0 = acc[ai][bj][m][0], v1 = acc[ai][bj][m][1];
                    u32x4 w; w.x = cvt_pk_bf16(v0[0], v0[1]); w.y = cvt_pk_bf16(v0[2], v0[3]); w.z = cvt_pk_bf16(v1[0], v1[1]); w.w = cvt_pk_bf16(v1[2], v1[3]);
                    *(GAS u32x4*)(rowp + bj * HALF) = w; } }
    }
};
__device__ __forceinline__ void gn_gate_phase(Frame& F, const bf16* Y, bf16* G) {
    const int gw = F.vcu * NWAVES + F.wave, NGW = F.G * NWAVES;
    for (int item = gw; item < M * RH; item += NGW) {
        const size_t off = (size_t)item * RV + 8 * F.lane;
        const v4u yw = __builtin_nontemporal_load((const GAS v4u*)(Y + off)), gv = __builtin_nontemporal_load((const GAS v4u*)(G + off));
        float y[8] = {pg8::bf_lo(yw.x), pg8::bf_hi(yw.x), pg8::bf_lo(yw.y), pg8::bf_hi(yw.y), pg8::bf_lo(yw.z), pg8::bf_hi(yw.z), pg8::bf_lo(yw.w), pg8::bf_hi(yw.w)};
        float g[8] = {pg8::bf_lo(gv.x), pg8::bf_hi(gv.x), pg8::bf_lo(gv.y), pg8::bf_hi(gv.y), pg8::bf_lo(gv.z), pg8::bf_hi(gv.z), pg8::bf_lo(gv.w), pg8::bf_hi(gv.w)};
        float q = 0.f;
#pragma unroll
        for (int e = 0; e < 8; ++e) q += y[e] * y[e];
        const float r = rsqrtf(wave_sum(q) * (1.f / RV) + GN_EPS);
        v4u o; o.x = pk2(g[0] * y[0] * r, g[1] * y[1] * r); o.y = pk2(g[2] * y[2] * r, g[3] * y[3] * r); o.z = pk2(g[4] * y[4] * r, g[5] * y[5] * r); o.w = pk2(g[6] * y[6] * r, g[7] * y[7] * r);
        *(GAS v4u*)(G + off) = o;
    }
}
constexpr size_t WS_ST = WS_A1;
constexpr size_t WS_VTC = WS_A5;
constexpr size_t WS_KT = WS_A6;
constexpr size_t WS_PD = WS_WM1;
constexpr size_t WS_Q2 = 880 * MiB, WS_K2 = 944 * MiB;

struct EpiRetProj2 {
    static constexpr bool PERM = true;
    unsigned short *Q2, *K2; const float *tcos, *tsin, *rotd; const float* sx; float sw;
    __device__ __forceinline__ void operator()(const pg8::f32x4 (&acc)[2][2][4][2], const pg8::Unit& u, int wr, int wc, int fr, int fq) const {
        using namespace pg8;
        const int i0 = wc * 32 + 8 * fq, h = u.pn & 7, b = u.pm >> 3, cc = u.pm & 7, z = b * RH + h; const bool isk = u.pn >= 8;
        unsigned short* base = isk ? K2 : Q2; const float sc = (isk ? 0.0625f : 1.0f) * sw;
        const int iw0 = wr * 64 + fr;
        const int sb0 = cc * 256 + iw0;
        float rsx[2][4];
#pragma unroll
        for (int ai = 0; ai < 2; ++ai)
#pragma unroll
            for (int m = 0; m < 4; ++m) rsx[ai][m] = sx[b * SEQ + sb0 + ai * HALF + m * 16];
        f32x4 c[2], s[2], c16[2], s16[2];
#pragma unroll
        for (int j = 0; j < 2; ++j) { c[j] = *(const GAS f32x4*)(tcos + sb0 * 128 + i0 + 4 * j); s[j] = *(const GAS f32x4*)(tsin + sb0 * 128 + i0 + 4 * j);
            c16[j] = *(const GAS f32x4*)(rotd + i0 + 4 * j); s16[j] = *(const GAS f32x4*)(rotd + 128 + i0 + 4 * j); }
#pragma unroll
        for (int ai = 0; ai < 2; ++ai) {
#pragma unroll
            for (int m = 0; m < 4; ++m) { const int st = sb0 + ai * HALF + m * 16; const float rs = rsx[ai][m];
                const f32x4 a0 = i2f4(acc[ai][0][m][0]) * rs, a1 = i2f4(acc[ai][0][m][1]) * rs, b0 = i2f4(acc[ai][1][m][0]) * rs, b1 = i2f4(acc[ai][1][m][1]) * rs;
                const f32x4 o10 = (a0 * c[0] - b0 * s[0]) * sc, o11 = (a1 * c[1] - b1 * s[1]) * sc, o20 = (a0 * s[0] + b0 * c[0]) * sc, o21 = (a1 * s[1] + b1 * c[1]) * sc;
                unsigned short* dst = base + ((size_t)z * SEQ + st) * RQK + i0;
                u32x4 w1, w2; w1.x = cvt_pk_bf16(o10[0], o10[1]); w1.y = cvt_pk_bf16(o10[2], o10[3]); w1.z = cvt_pk_bf16(o11[0], o11[1]); w1.w = cvt_pk_bf16(o11[2], o11[3]);
                w2.x = cvt_pk_bf16(o20[0], o20[1]); w2.y = cvt_pk_bf16(o20[2], o20[3]); w2.z = cvt_pk_bf16(o21[0], o21[1]); w2.w = cvt_pk_bf16(o21[2], o21[3]);
                *(GAS u32x4*)dst = w1; *(GAS u32x4*)(dst + 128) = w2;
                const int nrot = (ai == 1 && m == 3) ? 0 : (m == 3 ? 5 : 1);
#pragma unroll
                for (int q = 0; q < nrot; ++q)
#pragma unroll
                    for (int j = 0; j < 2; ++j) { const f32x4 cn = c[j] * c16[j] - s[j] * s16[j], sn = s[j] * c16[j] + c[j] * s16[j]; c[j] = cn; s[j] = sn; } }
        }
    }
};
struct EpiVtCat {
    static constexpr bool PERM = true;
    unsigned short* VTC; const float* sx; float sw;
    __device__ __forceinline__ void operator()(const pg8::f32x4 (&acc)[2][2][4][2], const pg8::Unit& u, int wr, int wc, int fr, int fq) const {
        using namespace pg8;
        const int h = u.pm >> 1, dv0 = (u.pm & 1) * 256, b = u.pn >> 3, cc = u.pn & 7;
        unsigned short* base = VTC + ((size_t)((b * RH + h) * 8 + cc) * RV + dv0 + wr * 64 + fr) * 256 + wc * 32 + 8 * fq;
        f32x4 cs[2][2];
#pragma unroll
        for (int bj = 0; bj < 2; ++bj) { const float* sp = sx + u.pn * 256 + bj * HALF + wc * 32 + 8 * fq; cs[bj][0] = *(const GAS f32x4*)sp * sw; cs[bj][1] = *(const GAS f32x4*)(sp + 4) * sw; }
#pragma unroll
        for (int ai = 0; ai < 2; ++ai)
#pragma unroll
            for (int m = 0; m < 4; ++m) { unsigned short* rowp = base + (size_t)(ai * HALF + m * 16) * 256;
#pragma unroll
                for (int bj = 0; bj < 2; ++bj) { const f32x4 v0 = i2f4(acc[ai][bj][m][0]) * cs[bj][0], v1 = i2f4(acc[ai][bj][m][1]) * cs[bj][1];
                    u32x4 w; w.x = cvt_pk_bf16(v0[0], v0[1]); w.y = cvt_pk_bf16(v0[2], v0[3]); w.z = cvt_pk_bf16(v1[0], v1[1]); w.w = cvt_pk_bf16(v1[2], v1[3]);
                    *(GAS u32x4*)(rowp + bj * HALF) = w; } }
    }
};
struct PairOrder {
    static constexpr bool GATHER = false, CARRY = false; static constexpr int MODE = 2;
    const char* A; const char* B; int G, c;
    __device__ __forceinline__ bool next(int i, pg8::Unit& u) const { const int p = c + (i >> 1) * G; if (p >= 512) return false; u.pm = p >> 3; u.pn = (p & 7) + 8 * (i & 1); u.z = 0; u.aux = 0; return true; }
    __device__ __forceinline__ const char* abase(const pg8::Unit& u) const { return A + (size_t)u.pm * 256 * D * 2; }
    __device__ __forceinline__ const char* bbase(const pg8::Unit& u) const { return B + (size_t)u.pn * 256 * D * 2; }
    __device__ __forceinline__ unsigned arow(const pg8::Unit&, int r) const { return (unsigned)r; }
    __device__ __forceinline__ void a_ready(const pg8::Unit&) const {}
    __device__ __forceinline__ void done(const pg8::Unit&) const {}
};
struct DiagOrder {
    static constexpr bool GATHER = false, CARRY = false;
    const char* Q; const char* K; int p0, pstep, npairs;
    __device__ __forceinline__ bool next(int i, pg8::Unit& u) const { if (i >= npairs) return false; const int p = p0 + i * pstep; const int pm = p >> 3; u.z = (pm >> 3) * 8 + (p & 7); u.pm = pm & 7; u.pn = pm & 7; u.aux = 0; return true; }
    __device__ __forceinline__ const char* abase(const pg8::Unit& u) const { return Q + ((size_t)u.z * SEQ + u.pm * 256) * RQK * 2; }
    __device__ __forceinline__ const char* bbase(const pg8::Unit& u) const { return K + ((size_t)u.z * SEQ + u.pm * 256) * RQK * 2; }
    __device__ __forceinline__ unsigned arow(const pg8::Unit&, int r) const { return (unsigned)r; }
    __device__ __forceinline__ void a_ready(const pg8::Unit&) const {}
    __device__ __forceinline__ void done(const pg8::Unit&) const {}
};
struct EpiDiag {
    static constexpr bool PERM = true;
    unsigned short* PD; const float* lg2;
    __device__ __forceinline__ void operator()(const pg8::f32x4 (&acc)[2][2][4][2], const pg8::Unit& u, int wr, int wc, int fr, int fq) const {
        using namespace pg8;
        const int h = u.z & 7; const float lf = lg2[2 * h], lb = lg2[2 * h + 1];
        int r0 = wr * 64 + fr, c0 = wc * 32 + 8 * fq;
        asm volatile("" : "+v"(r0), "+v"(c0));
        unsigned short* base = PD + (size_t)(u.z * 8 + u.pm) * 256 * 256;
#pragma unroll
        for (int ai = 0; ai < 2; ++ai)
#pragma unroll
            for (int m = 0; m < 4; ++m) { const int r = r0 + ai * HALF + m * 16; unsigned short* rowp = base + (size_t)r * 256 + c0;
#pragma unroll
                for (int bj = 0; bj < 2; ++bj) { float f[8];
#pragma unroll
                    for (int k = 0; k < 8; ++k) { const int d = r - (c0 + bj * HALF + k); f[k] = __builtin_amdgcn_exp2f(d >= 0 ? lf * (float)d : lb * (float)(-d)); }
                    const f32x4 v0 = acc[ai][bj][m][0], v1 = acc[ai][bj][m][1];
                    u32x4 w; w.x = cvt_pk_bf16(v0[0] * f[0], v0[1] * f[1]); w.y = cvt_pk_bf16(v0[2] * f[2], v0[3] * f[3]); w.z = cvt_pk_bf16(v1[0] * f[4], v1[1] * f[5]); w.w = cvt_pk_bf16(v1[2] * f[6], v1[3] * f[7]);
                    *(GAS u32x4*)(rowp + bj * HALF) = w; __builtin_amdgcn_sched_barrier(0); } }
    }
};
__device__ __forceinline__ void kt_phase(Frame& F, const bf16* K2, bf16* KT, const float* lg2, int p0, int pstep, int npairs) {
    constexpr int LDT = 72;
    LAS bf16* T = (LAS bf16*)(F.lds + RING_OFF + F.wave * 16384);
    const int lane = F.lane, q = lane & 7, rr = lane >> 3;
    for (int it = F.wave; it < 16 * npairs; it += NWAVES) {
        const int p = p0 + (it >> 4) * pstep, blk = it & 15, pm = p >> 3, z = (pm >> 3) * 8 + (p & 7), h = z & 7, s0 = (pm & 7) * 256 + (blk >> 2) * 64, dk0 = (blk & 3) * 64;
        v4u v[8];
#pragma unroll
        for (int i = 0; i < 8; ++i) v[i] = *(const GAS v4u*)(K2 + ((size_t)z * SEQ + s0 + rr + 8 * i) * RQK + dk0 + 8 * q);
#pragma unroll
        for (int i = 0; i < 8; ++i) { const int sl = rr + 8 * i; const unsigned w4[4] = {v[i].x, v[i].y, v[i].z, v[i].w};
#pragma unroll
            for (int e = 0; e < 8; ++e) T[(8 * q + e) * LDT + sl] = (bf16)((e & 1) ? (w4[e >> 1] >> 16) : (w4[e >> 1] & 0xffffu)); }
        LDS_WAIT(); asm volatile("" ::: "memory");
        const float lf = lg2[2 * h], lb = lg2[2 * h + 1];
        float ff[8], fb[8];
#pragma unroll
        for (int e = 0; e < 8; ++e) { const int j = (s0 + 8 * q + e) & 255; ff[e] = __builtin_amdgcn_exp2f(lf * (float)(256 - j)); fb[e] = __builtin_amdgcn_exp2f(lb * (float)j); }
#pragma unroll
        for (int jj = 0; jj < 8; ++jj) { const int dk = rr + 8 * jj; const v4u t = *(const LAS v4u*)(T + dk * LDT + 8 * q);
            const float x[8] = {pg8::bf_lo(t.x), pg8::bf_hi(t.x), pg8::bf_lo(t.y), pg8::bf_hi(t.y), pg8::bf_lo(t.z), pg8::bf_hi(t.z), pg8::bf_lo(t.w), pg8::bf_hi(t.w)};
            v4u of, ob;
            of.x = pk2(x[0] * ff[0], x[1] * ff[1]); of.y = pk2(x[2] * ff[2], x[3] * ff[3]); of.z = pk2(x[4] * ff[4], x[5] * ff[5]); of.w = pk2(x[6] * ff[6], x[7] * ff[7]);
            ob.x = pk2(x[0] * fb[0], x[1] * fb[1]); ob.y = pk2(x[2] * fb[2], x[3] * fb[3]); ob.z = pk2(x[4] * fb[4], x[5] * fb[5]); ob.w = pk2(x[6] * fb[6], x[7] * fb[7]);
            bf16* d = KT + ((size_t)(z * 2) * RQK + dk0 + dk) * SEQ + s0 + 8 * q;
            *(GAS v4u*)d = of; *(GAS v4u*)(d + (size_t)RQK * SEQ) = ob; }
        LDS_WAIT(); asm volatile("" ::: "memory");
    }
    __syncthreads();
}
struct ChainOrder {
    static constexpr bool GATHER = false, CARRY = true;
    const char* A; const char* B; const float* lg2; int G, c;
    __device__ __forceinline__ bool next(int i, pg8::Unit& u) const {
        const int ch = c + (i / 7) * G; if (ch >= 256) return false; const int st = i % 7, dir = (ch >> 1) & 1;
        u.z = ch >> 2; u.aux = ch & 3; u.pn = dir ? 7 - st : st; u.pm = dir ? 6 - st : st + 1; return true;
    }
    __device__ __forceinline__ const char* abase(const pg8::Unit& u) const { return A + ((size_t)(u.z * 8 + u.pn) * RV + (u.aux & 1) * 256) * 256 * 2; }
    __device__ __forceinline__ const char* bbase(const pg8::Unit& u) const { return B + (((size_t)(u.z * 2 + (u.aux >> 1)) * RQK) * SEQ + u.pn * 256) * 2; }
    __device__ __forceinline__ unsigned arow(const pg8::Unit&, int r) const { return (unsigned)r; }
    __device__ __forceinline__ float carry(const pg8::Unit& cur, const pg8::Unit& nxt, int) const {
        return (cur.z == nxt.z && cur.aux == nxt.aux) ? __builtin_amdgcn_exp2f(lg2[2 * (cur.z & 7) + (cur.aux >> 1)] * 256.0f) : 0.0f; }
    __device__ __forceinline__ void a_ready(const pg8::Unit&) const {}
    __device__ __forceinline__ void done(const pg8::Unit&) const {}
};
struct EpiState {
    static constexpr bool PERM = true;
    unsigned short* ST;
    __device__ __forceinline__ void operator()(const pg8::f32x4 (&acc)[2][2][4][2], const pg8::Unit& u, int wr, int wc, int fr, int fq) const {
        using namespace pg8;
        unsigned short* base = ST + ((size_t)((u.z * 8 + u.pm) * 2 + (u.aux >> 1)) * RV + (u.aux & 1) * 256 + wr * 64 + fr) * 256 + wc * 32 + 8 * fq;
#pragma unroll
        for (int ai = 0; ai < 2; ++ai)
#pragma unroll
            for (int m = 0; m < 4; ++m) { unsigned short* rowp = base + (size_t)(ai * HALF + m * 16) * 256;
#pragma unroll
                for (int bj = 0; bj < 2; ++bj) { const f32x4 v0 = acc[ai][bj][m][0], v1 = acc[ai][bj][m][1];
                    u32x4 w; w.x = cvt_pk_bf16(v0[0], v0[1]); w.y = cvt_pk_bf16(v0[2], v0[3]); w.z = cvt_pk_bf16(v1[0], v1[1]); w.w = cvt_pk_bf16(v1[2], v1[3]);
                    *(GAS u32x4*)(rowp + bj * HALF) = w; } }
    }
};
__device__ __forceinline__ void chain_zero(Frame& F, bf16* ST) {
    for (int ch = F.vcu; ch < 256; ch += F.G) { const int z = ch >> 2, dir = (ch >> 1) & 1, dvh = ch & 1;
        bf16* base = ST + ((size_t)((z * 8 + (dir ? 7 : 0)) * 2 + dir) * RV + dvh * 256) * 256;
        for (int k = F.tid; k < 256 * 32; k += NWAVES * 64) *(GAS v4u*)(base + (size_t)k * 8) = (v4u){0u, 0u, 0u, 0u}; }
}
struct YOrder {
    static constexpr bool GATHER = false, CARRY = true;
    const char* Q; const char* PD; const char* VTC; const char* ST; const char* Z0; const float* lg2; int G, c;
    __device__ __forceinline__ bool next(int i, pg8::Unit& u) const { const int L = (i / 3) * G + c; if (L >= 1024) return false; const int zc = L >> 1; u.z = zc >> 3; u.pm = zc & 7; u.pn = L & 1; u.aux = i % 3; return true; }
    __device__ __forceinline__ const char* abase(const pg8::Unit& u) const { return (u.aux == 1 ? PD : Q) + (size_t)(u.z * 8 + u.pm) * 256 * 256 * 2; }
    __device__ __forceinline__ const char* bbase(const pg8::Unit& u) const {
        if ((u.aux == 2 && u.pm == 0) || (u.aux == 0 && u.pm == 7)) return Z0;
        return u.aux == 1 ? VTC + ((size_t)(u.z * 8 + u.pm) * RV + u.pn * 256) * 256 * 2 : ST + ((size_t)((u.z * 8 + u.pm) * 2 + (u.aux == 0 ? 1 : 0)) * RV + u.pn * 256) * 256 * 2; }
    __device__ __forceinline__ unsigned arow(const pg8::Unit&, int r) const { return (unsigned)r; }
    __device__ __forceinline__ float carry(const pg8::Unit& cur, const pg8::Unit&, int row) const {
        const int h = cur.z & 7;
        return cur.aux == 0 ? __builtin_amdgcn_exp2f(lg2[2 * h + 1] * (float)(256 - row)) : (cur.aux == 1 ? __builtin_amdgcn_exp2f(-lg2[2 * h] * (float)row) : 0.0f); }
    __device__ __forceinline__ void a_ready(const pg8::Unit&) const {}
    __device__ __forceinline__ void done(const pg8::Unit&) const {}
};
struct EpiYOut {
    static constexpr bool PERM = true;
    unsigned short* Y; float* gpart; const float* lg2;
    __device__ __forceinline__ void operator()(const pg8::f32x4 (&acc)[2][2][4][2], const pg8::Unit& u, int wr, int wc, int fr, int fq) const {
        using namespace pg8;
        if (u.aux != 2) return;
        const int b = u.z >> 3, h = u.z & 7; const float lf = lg2[2 * h];
        unsigned short* base = Y + ((size_t)b * SEQ + u.pm * 256 + wr * 64 + fr) * RVW + h * RV + u.pn * 256 + wc * 32 + 8 * fq;
        float sq[2][4];
#pragma unroll
        for (int ai = 0; ai < 2; ++ai)
#pragma unroll
            for (int m = 0; m < 4; ++m) { unsigned short* rowp = base + (size_t)(ai * HALF + m * 16) * RVW; float t2 = 0.f; const float cf = __builtin_amdgcn_exp2f(lf * (float)(ai * HALF + wr * 64 + m * 16 + fr));
#pragma unroll
                for (int bj = 0; bj < 2; ++bj) { const f32x4 v0 = acc[ai][bj][m][0] * cf, v1 = acc[ai][bj][m][1] * cf;
                    u32x4 w; w.x = cvt_pk_bf16(v0[0], v0[1]); w.y = cvt_pk_bf16(v0[2], v0[3]); w.z = cvt_pk_bf16(v1[0], v1[1]); w.w = cvt_pk_bf16(v1[2], v1[3]);
                    *(GAS u32x4*)(rowp + bj * HALF) = w;
                    const float q0 = bf_lo(w.x), q1 = bf_hi(w.x), q2 = bf_lo(w.y), q3 = bf_hi(w.y), q4 = bf_lo(w.z), q5 = bf_hi(w.z), q6 = bf_lo(w.w), q7 = bf_hi(w.w);
                    t2 += ((q0 * q0 + q1 * q1) + (q2 * q2 + q3 * q3)) + ((q4 * q4 + q5 * q5) + (q6 * q6 + q7 * q7)); }
                t2 += __shfl_xor(t2, 16); t2 += __shfl_xor(t2, 32); sq[ai][m] = t2; }
#pragma unroll
        for (int ai = 0; ai < 2; ++ai) {
            const float v2 = fq == 0 ? sq[ai][0] : (fq == 1 ? sq[ai][1] : (fq == 2 ? sq[ai][2] : sq[ai][3]));
            const int tok = b * SEQ + u.pm * 256 + ai * HALF + wr * 64 + 16 * fq + fr;
            gpart[(size_t)(u.pn * 4 + wc) * (M * RH) + (size_t)tok * RH + h] = v2;
        }
    }
};
constexpr float Z_SCALE = 8.0f;
struct EpiGateNorm {
    static constexpr bool PERM = true;
    unsigned char* Z; const unsigned short* Y; const float* gpart; const float* sx; float sw;
    __device__ __forceinline__ void operator()(const pg8::f32x4 (&acc)[2][2][4][2], const pg8::Unit& u, int wr, int wc, int fr, int fq) const {
        using namespace pg8;
        const int h = u.pn >> 1, row0 = u.pm * BM + wr * 64 + fr, col0 = u.pn * BM + wc * 32 + 8 * fq;
        float s2[2][4];
#pragma unroll
        for (int ai = 0; ai < 2; ++ai)
#pragma unroll
            for (int m = 0; m < 4; ++m) { const float* gp = gpart + (size_t)(row0 + ai * HALF + m * 16) * RH + h;
                s2[ai][m] = gp[(size_t)(2 * fq) * (M * RH)] + gp[(size_t)(2 * fq + 1) * (M * RH)]; }
        float rn[2][4];
#pragma unroll
        for (int ai = 0; ai < 2; ++ai)
#pragma unroll
            for (int m = 0; m < 4; ++m) { float t = s2[ai][m]; t += __shfl_xor(t, 16); t += __shfl_xor(t, 32); rn[ai][m] = rsqrtf(t * (1.f / RV) + GN_EPS); }
        float rsx[2][4];
#pragma unroll
        for (int ai = 0; ai < 2; ++ai)
#pragma unroll
            for (int m = 0; m < 4; ++m) rsx[ai][m] = sx[row0 + ai * HALF + m * 16] * sw;
#pragma unroll
        for (int ai = 0; ai < 2; ++ai) {
            u32x4 yw[4][2];
#pragma unroll
            for (int m = 0; m < 4; ++m)
#pragma unroll
                for (int bj = 0; bj < 2; ++bj) yw[m][bj] = __builtin_nontemporal_load((const GAS u32x4*)(Y + (size_t)(row0 + ai * HALF + m * 16) * RVW + col0 + bj * HALF));
#pragma unroll
            for (int m = 0; m < 4; ++m) { const float r1 = rn[ai][m] * Z_SCALE; const size_t off = (size_t)(row0 + ai * HALF + m * 16) * RVW + col0;
#pragma unroll
                for (int bj = 0; bj < 2; ++bj) { const u32x4 y4 = yw[m][bj]; const f32x4 v0 = i2f4(acc[ai][bj][m][0]) * rsx[ai][m], v1 = i2f4(acc[ai][bj][m][1]) * rsx[ai][m];
                    u32x2 w; w.x = pk4_fp8(silu_f(v0[0]) * bf_lo(y4.x) * r1, silu_f(v0[1]) * bf_hi(y4.x) * r1, silu_f(v0[2]) * bf_lo(y4.y) * r1, silu_f(v0[3]) * bf_hi(y4.y) * r1);
                    w.y = pk4_fp8(silu_f(v1[0]) * bf_lo(y4.z) * r1, silu_f(v1[1]) * bf_hi(y4.z) * r1, silu_f(v1[2]) * bf_lo(y4.w) * r1, silu_f(v1[3]) * bf_hi(y4.w) * r1);
                    *(GAS u32x2*)(Z + off + bj * HALF) = w; } }
        }
    }
};
struct Args { const float* in[17]; float* out; unsigned char* ws; int ph_lo, ph_hi; };
__global__ void __launch_bounds__(NWAVES * 64, 2) fwd(Args args) {
    extern __shared__ __attribute__((aligned(16))) unsigned char lds[];
    Frame F;
    F.lds = (LAS unsigned char*)lds;
    F.MISC = (volatile LAS unsigned*)(F.lds + MISC_OFF);
    F.tid = threadIdx.x; F.lane = F.tid & 63; F.wave = __builtin_amdgcn_readfirstlane(F.tid >> 6);
    F.G = gridDim.x; { const int bx = blockIdx.x; F.vcu = (F.G % 8 == 0) ? (bx % 8) * (F.G / 8) + bx / 8 : bx; }
    F.ws = args.ws;
    unsigned char* ws = args.ws;
    F.ctl = (gu32*)(ws + WS_CTL);
    Ins I;
    I.x = args.in[0]; I.awin = args.in[1]; I.awout = args.in[2]; I.rpb = args.in[3]; I.rwin = args.in[4]; I.rwout = args.in[5]; I.dfw = args.in[6]; I.dbw = args.in[7];
    I.wgr = args.in[8]; I.bgr = args.in[9]; I.wer = args.in[10]; I.ber = args.in[11]; I.wgate = args.in[12]; I.wup = args.in[13]; I.wdown = args.in[14]; I.lng = args.in[15]; I.lnb = args.in[16];
    for (int u = F.tid; u < (LDS_BYTES - LDSCTL_OFF) / 4; u += NWAVES * 64) ((LAS unsigned*)(F.lds + LDSCTL_OFF))[u] = 0u;
    __syncthreads();
    XcdBarrier bar = xcd_barrier_post((unsigned*)(F.ctl + CW_BAR), F.MISC + 8);
    const int lo = args.ph_lo, hi = args.ph_hi;
#define IN(k) (lo <= (k) && (k) < hi)
#define BOTH(k) (IN(k) && IN((k) + 1))
#define GRID_BAR() xcd_barrier(bar)
#define REPS(k) (((REPEAT_MASK >> (k)) & 1u) ? 2 : 1)
    unsigned char* XF8 = ws + WS_A0; unsigned char* O8 = ws + WS_A0 + 32 * MiB; unsigned char* QB = ws + WS_A1; unsigned char* VT = ws + WS_A3;
    unsigned char* WAIN = ws + WS_WAIN;
#define FSC_INV1(IDX) __uint_as_float((unsigned)(127 - ((const GAS int*)F.ctl)[CW_FSC + (IDX)]) << 23)

    if (IN(0)) { for (int rep = 0; rep < REPS(0); ++rep) p0_prologue(I, F); if (BOTH(0)) GRID_BAR(); }

    if (IN(1)) {
        if (F.vcu & 1) conv_rest(I, F);
        for (int rep = 0; rep < REPS(1); ++rep) {
        { pg8::Gemm g{D / 2, D / 2, D / 2}; typedef pg8::DenseOrderT<M / 256, 4096 / 256, 1, 1> DO_; DO_ S; S.init(XF8, WAIN, D / 2, D / 2, 0, 0, F.G, (int)blockIdx.x);
          EpiF8 E{QB, D, D, (size_t)(WS_A2 - WS_A1), FSC_INV1(4), FSC_INV1(4)};
          pg8::gemm_phase<EpiF8, DO_, true>(F.lds + RING_OFF, g, S, E); }
        { pg8::Gemm g{D / 2, D / 2, D / 2}; typedef pg8::DenseOrderT<D / 256, M / 256, 1, 1> DO_; DO_ S; S.init(WAIN + (size_t)4096 * D, XF8, D / 2, D / 2, 0, 0, F.G, (int)blockIdx.x);
          EpiF8 E{VT, SEQ, SEQ, (size_t)D * SEQ, FSC_INV1(4) * natt::ATT_V_SCALE, FSC_INV1(4) * natt::ATT_V_SCALE};
          pg8::gemm_phase<EpiF8, DO_, true>(F.lds + RING_OFF, g, S, E); } }
        if (!(F.vcu & 1)) conv_rest(I, F);
        if (BOTH(1)) GRID_BAR();
    }
    if (IN(2)) {
        if (F.vcu & 1) conv_l0(I, F, MOE_ITEMS / 2, MOE_ITEMS);
        for (int rep = 0; rep < REPS(2); ++rep) natt::attn_phase(F.lds + RING_OFF, QB, ws + WS_A2, VT, O8, I.rpb, F.G, F.vcu);
        if (!(F.vcu & 1)) { __syncthreads(); conv_l0(I, F, MOE_ITEMS / 2, MOE_ITEMS); }
        if (BOTH(2)) GRID_BAR();
    }
    if (IN(3)) { if (F.vcu & 1) conv_ret(I, F);
        for (int rep = 0; rep < REPS(3); ++rep) {
        pg8::Gemm g{D / 2, D / 2, D / 2}; typedef pg8::DenseOrderT<M / 256, D / 256, 1, 1> DO_; DO_ S; S.init(O8, ws + WS_WAOUT, D / 2, D / 2, 0, 0, F.G, (int)blockIdx.x);
        EpiResStats<false> E{(const void*)I.x, (bf16*)(ws + WS_A4), (float*)(ws + WS_PART), FSC_INV1(5) * (1.0f / natt::ATT_O_SCALE)};
        pg8::gemm_phase<EpiResStats<false>, DO_, true>(F.lds + RING_OFF, g, S, E); }
        if (!(F.vcu & 1)) conv_ret(I, F);
        if (BOTH(3)) GRID_BAR();
    }
    unsigned* cnt0 = (unsigned*)(ws + WS_CTL) + CW_CNT; int* list = (int*)(ws + WS_LIST); float* routew = (float*)(ws + WS_ROUTEW);
    LAS int* mtab = (LAS int*)(F.lds + LDSCTL_OFF + 1024);
    if (IN(4)) {
        for (int rep = 0; rep < REPS(4); ++rep) ln_router_phase(F, (const bf16*)(ws + WS_A4), (const float*)(ws + WS_PART), I.lng, I.lnb, (bf16*)(ws + WS_A1), ws + WS_A2, ws + WS_WRF, I.bgr, I.ber, cnt0, list, routew, rep == 0);
        if (BOTH(4)) GRID_BAR();
    }
#define FSC_INV(LY, KIND) __uint_as_float((unsigned)(127 - ((const GAS int*)F.ctl)[CW_FSC + (LY) * 2 + (KIND)]) << 23)
#define MOE_LAYER(CNT, XSRC, HBUF, OBUF, PH, LY)                                                                                                                                        \
    if (IN(PH)) {                                                                                                                                                                     \
        moe_build_table(F, mtab, CNT);                                                                                                                                                \
        const int T_ = mtab[32], U1_ = 4 * T_, Xn_ = (U1_ / F.G) * F.G;                                                                                                               \
        for (int rep = 0; rep < REPS(PH); ++rep) {                                                                                                                                    \
        pg8::Gemm g{D / 2, D / 2, D / 2}; MoeOrder<true> S{mtab, CNT, list, (const char*)(XSRC), (const char*)(ws + WS_WM1), 0, (size_t)1024 * D, (size_t)256 * D, 4, F.G, F.vcu, 0, Xn_, 0, 0}; \
        EpiSwiGLU E{(unsigned char*)(HBUF), FSC_INV(LY, 0)};                                                                                                                                                   \
        pg8::gemm_phase<EpiSwiGLU, MoeOrder<true>, true>(F.lds + RING_OFF, g, S, E); }                                                                                                \
        if (BOTH(PH)) GRID_BAR();                                                                                                                                                     \
    }                                                                                                                                                                                 \
    if (IN(PH + 1)) {                                                                                                                                                                 \
        moe_build_table(F, mtab, CNT);                                                                                                                                                \
        const int T_ = mtab[32], U1_ = 4 * T_, Xn_ = (U1_ / F.G) * F.G, nleft_ = U1_ - Xn_, U2y_ = 8 * (Xn_ / 4), U2_ = 8 * T_;                                                       \
        for (int rep = 0; rep < REPS(PH + 1); ++rep) {                                                                                                                                \
        { pg8::Gemm g{D / 2, D / 2, D / 2}; MoeOrder<true> S{mtab, CNT, list, (const char*)(XSRC), (const char*)(ws + WS_WM1), 0, (size_t)1024 * D, (size_t)256 * D, 4, F.G, F.vcu, Xn_, U1_, 0, 0}; \
          EpiSwiGLU E{(unsigned char*)(HBUF), FSC_INV(LY, 0)};                                                                                                                                                 \
          pg8::gemm_phase<EpiSwiGLU, MoeOrder<true>, true>(F.lds + RING_OFF, g, S, E); }                                                                                              \
        { pg8::Gemm g{FF / 2, FF / 2, FF / 2}; MoeOrder<false> S{mtab, CNT, list, (const char*)(HBUF), (const char*)(ws + WS_WM2), (size_t)256 * FF, (size_t)D * FF, (size_t)256 * FF, 8, F.G, F.vcu, 0, U2y_, nleft_, 3}; \
          EpiScatter E{CNT, list, (unsigned char*)(OBUF), FSC_INV(LY, 1) * O_SCALE};                                                                                                                                     \
          pg8::gemm_phase<EpiScatter, MoeOrder<false>, true>(F.lds + RING_OFF, g, S, E); }                                                                                            \
        GRID_BAR();                                                                                                                                                                   \
        { pg8::Gemm g{FF / 2, FF / 2, FF / 2}; MoeOrder<false> S{mtab, CNT, list, (const char*)(HBUF), (const char*)(ws + WS_WM2), (size_t)256 * FF, (size_t)D * FF, (size_t)256 * FF, 8, F.G, F.vcu, U2y_, U2_, 0, 0}; \
          EpiScatter E{CNT, list, (unsigned char*)(OBUF), FSC_INV(LY, 1) * O_SCALE};                                                                                                                                     \
          pg8::gemm_phase<EpiScatter, MoeOrder<false>, true>(F.lds + RING_OFF, g, S, E); } }                                                                                          \
        if (BOTH(PH + 1)) GRID_BAR();                                                                                                                                                 \
    }
    MOE_LAYER(cnt0, ws + WS_A2, ws + WS_A6, ws + WS_A5, 5, 0)
    if (IN(7)) {
        for (int rep = 0; rep < REPS(7); ++rep) combine_ln_phase<false>(F, (const bf16*)(ws + WS_A4), (const float*)(ws + WS_PART), I.lng, I.lnb, (const unsigned char*)(ws + WS_A5), routew, I.lng + D, I.lnb + D, (bf16*)(ws + WS_A0), nullptr, ws + WS_X2I8, (float*)(ws + WS_SX));
        if (BOTH(7)) GRID_BAR();
    }
    bf16* X2 = (bf16*)(ws + WS_A0); bf16* Q2 = (bf16*)(ws + WS_Q2); bf16* K2 = (bf16*)(ws + WS_K2); bf16* PD = (bf16*)(ws + WS_PD); bf16* VTC = (bf16*)(ws + WS_VTC); bf16* STB = (bf16*)(ws + WS_ST); bf16* KTB = (bf16*)(ws + WS_KT);
    bf16* GZ = (bf16*)(ws + WS_A5); bf16* YR = (bf16*)(ws + WS_A6); unsigned char* WRIN = ws + WS_WRIN;
    const unsigned char* X2I8 = ws + WS_X2I8; const float* SX = (const float*)(ws + WS_SX);
#define RW_SC(PART) (((const GAS float*)F.ctl)[CW_FSC + 8 + (PART)] * (1.f / 127.f))
    const float* lg2t = (const float*)(ws + WS_DECAY);
    if (IN(8)) { for (int rep = 0; rep < REPS(8); ++rep) {
        int p0_, pstep_, npairs_;
        if (F.G == 256) {
            pg8::Gemm g{D / 2, D / 2, D / 2}; typedef pg8::DenseOrderT<M / 256, 4096 / 256, 1, 2> DQ_; DQ_ S; S.init(X2I8, WRIN, D / 2, D / 2, 0, 0, F.G, (int)blockIdx.x);
            EpiRetProj2 E{Q2, K2, (const float*)(ws + WS_TAB), (const float*)(ws + WS_TAB) + 2048 * 128, (const float*)(ws + WS_ROTD), SX, RW_SC(0)};
            pg8::gemm_phase<EpiRetProj2, DQ_, true>(F.lds + RING_OFF, g, S, E);
            pg8::Unit u0; S.next(0, u0); p0_ = u0.pm * 8 + u0.pn; pstep_ = 4; npairs_ = 2;
        } else {
            pg8::Gemm g{D / 2, D / 2, D / 2}; PairOrder S{(const char*)X2I8, (const char*)WRIN, F.G, F.vcu};
            EpiRetProj2 E{Q2, K2, (const float*)(ws + WS_TAB), (const float*)(ws + WS_TAB) + 2048 * 128, (const float*)(ws + WS_ROTD), SX, RW_SC(0)};
            pg8::gemm_phase<EpiRetProj2, PairOrder, true>(F.lds + RING_OFF, g, S, E);
            p0_ = F.vcu; pstep_ = F.G; npairs_ = (512 - F.vcu + F.G - 1) / F.G; }
        { pg8::Gemm g{RQK, RQK, RQK}; DiagOrder S{(const char*)Q2, (const char*)K2, p0_, pstep_, npairs_};
          EpiDiag E{PD, lg2t};
          pg8::gemm_phase<EpiDiag, DiagOrder, true>(F.lds + RING_OFF, g, S, E); }
        kt_phase(F, K2, KTB, lg2t, p0_, pstep_, npairs_);
        { pg8::Gemm g{D / 2, D / 2, D / 2}; typedef pg8::DenseOrderT<RVW / 256, M / 256, 1, 2> DO_; DO_ S; S.init(WRIN + (size_t)8192 * D, X2I8, D / 2, D / 2, 0, 0, F.G, (int)blockIdx.x);
          EpiVtCat E{VTC, SX, RW_SC(1)};
          pg8::gemm_phase<EpiVtCat, DO_, true>(F.lds + RING_OFF, g, S, E); } }
        if (BOTH(8)) GRID_BAR();
    }
    if (IN(10)) { for (int rep = 0; rep < REPS(10); ++rep) {
        pg8::Gemm g{256, SEQ, 256}; ChainOrder S{(const char*)VTC, (const char*)KTB, lg2t, F.G, F.vcu};
        EpiState E{STB};
        pg8::gemm_phase<EpiState, ChainOrder, true>(F.lds + RING_OFF, g, S, E); }
        if (BOTH(10)) GRID_BAR();
    }
    if (IN(11)) { for (int rep = 0; rep < REPS(11); ++rep) {
        pg8::Gemm g{256, 256, 256}; YOrder S{(const char*)Q2, (const char*)PD, (const char*)VTC, (const char*)STB, (const char*)(ws + WS_CTL + MiB), lg2t, F.G, F.vcu};
        EpiYOut E{YR, (float*)(ws + WS_PART), lg2t};
        pg8::gemm_phase<EpiYOut, YOrder, true>(F.lds + RING_OFF, g, S, E); }
        if (BOTH(11)) GRID_BAR();
    }
    if (IN(12)) { if (F.vcu & 1) conv_l1(I, F, 0, MOE_ITEMS / 2);
        for (int rep = 0; rep < REPS(12); ++rep) {
        pg8::Gemm g{D / 2, D / 2, D / 2}; typedef pg8::DenseOrderT<M / 256, RVW / 256, 1, 2> DO_; DO_ S; S.init(X2I8, WRIN + (size_t)4096 * D, D / 2, D / 2, 0, 0, F.G, (int)blockIdx.x);
        EpiGateNorm E{(unsigned char*)GZ, YR, (const float*)(ws + WS_PART), SX, RW_SC(2)};
        pg8::gemm_phase<EpiGateNorm, DO_, true>(F.lds + RING_OFF, g, S, E); }
        if (!(F.vcu & 1)) conv_l1(I, F, 0, MOE_ITEMS / 2);
        if (BOTH(12)) GRID_BAR();
    }
    if (IN(18)) {
        if (F.vcu & 1) conv_l1(I, F, MOE_ITEMS / 2, MOE_ITEMS);
        for (int rep = 0; rep < REPS(18); ++rep) {
        pg8::Gemm g{RVW / 2, RVW / 2, RVW / 2}; typedef pg8::DenseOrderT<M / 256, D / 256, 1, 1> DO_; DO_ S; S.init(GZ, ws + WS_WROUT, RVW / 2, RVW / 2, 0, 0, F.G, (int)blockIdx.x);
        EpiResStats<true> E{(const void*)X2, (bf16*)(ws + WS_A1), (float*)(ws + WS_PART), FSC_INV1(6) * (1.0f / Z_SCALE)};
        pg8::gemm_phase<EpiResStats<true>, DO_, true>(F.lds + RING_OFF, g, S, E); }
        if (!(F.vcu & 1)) conv_l1(I, F, MOE_ITEMS / 2, MOE_ITEMS);
        if (BOTH(18)) GRID_BAR();
    }
    unsigned* cnt1 = cnt0 + 2048;
    if (IN(19)) {
        for (int rep = 0; rep < REPS(19); ++rep) ln_router_phase(F, (const bf16*)(ws + WS_A1), (const float*)(ws + WS_PART), I.lng + 2 * D, I.lnb + 2 * D, (bf16*)(ws + WS_A2), ws + WS_A5, ws + WS_WRF + WRF_LAYER_BYTES, I.bgr + 4, I.ber + 32, cnt1, list, routew, rep == 0);
        if (BOTH(19)) GRID_BAR();
    }
    MOE_LAYER(cnt1, ws + WS_A5, ws + WS_A6, ws + WS_A3, 20, 1)
#undef MOE_LAYER
#undef FSC_INV
    if (IN(22)) {
        for (int rep = 0; rep < REPS(22); ++rep) combine_ln_phase<true>(F, (const bf16*)(ws + WS_A1), (const float*)(ws + WS_PART), I.lng + 2 * D, I.lnb + 2 * D, (const unsigned char*)(ws + WS_A3), routew, I.lng + 3 * D, I.lnb + 3 * D, nullptr, args.out);
    }
#undef IN
#undef BOTH
#undef GRID_BAR
}
#if DEBUG_STAGE != 0
namespace dbg {
__global__ __launch_bounds__(256) void cmp(const void* fast, int is_bf16, long fs_r, long fs_c, float fscale, const float* naive, long ns_r, long ns_c, int R, int C, float* acc2) {
    float e = 0.f, r = 0.f;
    for (long idx = (long)blockIdx.x * 256 + threadIdx.x; idx < (long)R * C; idx += (long)gridDim.x * 256) {
        const long i = idx / C, j = idx % C;
        float f; if (is_bf16) f = __uint_as_float(((unsigned)((const unsigned short*)fast)[i * fs_r + j * fs_c]) << 16); else f = ((const float*)fast)[i * fs_r + j * fs_c];
        const float n = naive[i * ns_r + j * ns_c]; const float d = f * fscale - n; e += d * d; r += n * n;
    }
#pragma unroll
    for (int o = 32; o >= 1; o >>= 1) { e += __shfl_xor(e, o); r += __shfl_xor(r, o); }
    if ((threadIdx.x & 63) == 0) { atomicAdd(acc2, e); atomicAdd(acc2 + 1, r); }
}
__global__ __launch_bounds__(256) void perturb(float* out, size_t n, const float* acc, int nchk) {
    float s = 0.f; for (int k = 0; k < nchk; ++k) s += acc[2 * k] / acc[2 * k + 1];
    const float f = 1.f + sqrtf(s);
    for (size_t i = (size_t)blockIdx.x * 256 + threadIdx.x; i < n; i += (size_t)gridDim.x * 256) out[i] *= f;
}
__global__ __launch_bounds__(256) void copy2d16(unsigned short* dst, long dp, const unsigned short* src, long sp, int R, int C) {
    for (long idx = (long)blockIdx.x * 256 + threadIdx.x; idx < (long)R * C; idx += (long)gridDim.x * 256) { const long i = idx / C, j = idx % C; dst[i * dp + j] = src[i * sp + j]; }
}
__global__ __launch_bounds__(256) void axpy(float* y, const float* x, float a, long n) { for (long i = (long)blockIdx.x * 256 + threadIdx.x; i < n; i += (long)gridDim.x * 256) y[i] += a * x[i]; }
}
#endif

#ifndef DBG_NCHK
#define DBG_NCHK 2
#endif
#ifndef DEBUG_STAGE
#define DEBUG_STAGE 0
#endif
extern "C" void kernel_launch(void* const* d_in, const int* in_sizes, int n_in, void* d_out, int out_size, void* d_ws, size_t ws_size, hipStream_t stream) {
    static int grid = 0;
    if (grid == 0) {
        if (n_in != 17 || in_sizes[0] != M * D || out_size != M * D || ws_size < (DEBUG_STAGE ? WS_END : WS_FAST_END)) { fprintf(stderr, "kernel_launch: unexpected shapes (n_in %d, ws %zu)\n", n_in, ws_size); grid = -1; return; }
        int dev = 0, cus = 0, per_cu = 0;
        if (hipGetDevice(&dev) != hipSuccess || hipDeviceGetAttribute(&cus, hipDeviceAttributeMultiprocessorCount, dev) != hipSuccess) { grid = -1; return; }
        if (hipFuncSetAttribute((const void*)fwd, hipFuncAttributeMaxDynamicSharedMemorySize, LDS_BYTES) != hipSuccess) { fprintf(stderr, "kernel_launch: hipFuncSetAttribute failed\n"); grid = -1; return; }
        if (hipOccupancyMaxActiveBlocksPerMultiprocessor(&per_cu, (const void*)fwd, NWAVES * 64, LDS_BYTES) != hipSuccess || per_cu < 1) { fprintf(stderr, "kernel_launch: occupancy query says %d\n", per_cu); (void)hipGetLastError(); grid = -1; return; }
        grid = cus;
    }
    if (grid < 0) return;
    unsigned char* ws = (unsigned char*)d_ws;
    if (hipMemsetAsync(ws + WS_CTL, 0, CTL_ZERO_BYTES, stream) != hipSuccess) return;
    Args a{};
    for (int i = 0; i < 17; ++i) a.in[i] = (const float*)d_in[i];
    a.out = (float*)d_out; a.ws = ws;
#if DEBUG_STAGE == 0
    a.ph_lo = 0; a.ph_hi = 64;
    hipLaunchKernelGGL(fwd, dim3(grid), dim3(NWAVES * 64), LDS_BYTES, stream, a);
#else
    nv::In NI; NI.x = a.in[0]; NI.awin = a.in[1]; NI.awout = a.in[2]; NI.rpb = a.in[3]; NI.rwin = a.in[4]; NI.rwout = a.in[5]; NI.dfw = a.in[6]; NI.dbw = a.in[7];
    NI.wgr = a.in[8]; NI.bgr = a.in[9]; NI.wer = a.in[10]; NI.ber = a.in[11]; NI.wgate = a.in[12]; NI.wup = a.in[13]; NI.wdown = a.in[14]; NI.lng = a.in[15]; NI.lnb = a.in[16];
    float* acc = (float*)(ws + WS_CTL) + CW_DBG; float* dbg1 = (float*)(ws + WS_DBG1); unsigned char* dbg2 = ws + WS_DBG2; float* nscr = (float*)(ws + WS_A0);
    int nchk = 0;
#if DEBUG_STAGE == 1
    a.ph_lo = 0; a.ph_hi = 2;
    hipLaunchKernelGGL(fwd, dim3(grid), dim3(NWAVES * 64), LDS_BYTES, stream, a);
    (void)hipMemcpyAsync(dbg2, ws + WS_A1, (size_t)2048 * 2048 * 2, hipMemcpyDeviceToDevice, stream);
    (void)hipMemcpyAsync(dbg2 + 8 * MiB, ws + WS_A2, (size_t)2048 * 2048 * 2, hipMemcpyDeviceToDevice, stream);
    hipLaunchKernelGGL(dbg::copy2d16, dim3(1024), dim3(256), 0, stream, (unsigned short*)(dbg2 + 16 * MiB), 2048L, (const unsigned short*)(ws + WS_A3), (long)M, 2048, 2048);
    nv::forward(NI, (float*)d_out, nscr, stream, 1u << 0, dbg1);
    hipLaunchKernelGGL(dbg::cmp, dim3(1024), dim3(256), 0, stream, (const void*)dbg2, 1, 2048L, 1L, 1.f / 0.08838834764831845f, (const float*)dbg1, 6144L, 1L, 2048, 2048, acc + 0);
    hipLaunchKernelGGL(dbg::cmp, dim3(1024), dim3(256), 0, stream, (const void*)(dbg2 + 8 * MiB), 1, 2048L, 1L, 1.f, (const float*)dbg1 + 2048, 6144L, 1L, 2048, 2048, acc + 2);
    hipLaunchKernelGGL(dbg::cmp, dim3(1024), dim3(256), 0, stream, (const void*)(dbg2 + 16 * MiB), 1, 1L, 2048L, 1.f, (const float*)dbg1 + 4096, 6144L, 1L, 2048, 2048, acc + 4);
    nchk = 3;
#endif
#if DEBUG_STAGE == 3
    a.ph_lo = 0; a.ph_hi = 8;
    hipLaunchKernelGGL(fwd, dim3(grid), dim3(NWAVES * 64), LDS_BYTES, stream, a);
    (void)hipMemcpyAsync(dbg2, ws + WS_A0, (size_t)2048 * 2048 * 2, hipMemcpyDeviceToDevice, stream);
    (void)hipMemcpyAsync(dbg2 + 8 * MiB, ws + WS_A1, (size_t)2048 * 2048 * 2, hipMemcpyDeviceToDevice, stream);
    nv::forward(NI, (float*)d_out, nscr, stream, (1u << 3) | (1u << 4), dbg1);
    hipLaunchKernelGGL(dbg::cmp, dim3(1024), dim3(256), 0, stream, (const void*)dbg2, 1, 2048L, 1L, 1.f, (const float*)dbg1 + (8u << 20), 2048L, 1L, 2048, 2048, acc + 0);
    hipLaunchKernelGGL(dbg::cmp, dim3(1024), dim3(256), 0, stream, (const void*)(dbg2 + 8 * MiB), 1, 2048L, 1L, 1.f, (const float*)dbg1 + (12u << 20), 2048L, 1L, 2048, 2048, acc + 2);
    nchk = DBG_NCHK;
#endif
#if DEBUG_STAGE == 2
    a.ph_lo = 0; a.ph_hi = 4;
    hipLaunchKernelGGL(fwd, dim3(grid), dim3(NWAVES * 64), LDS_BYTES, stream, a);
    (void)hipMemcpyAsync(dbg2, ws + WS_A1, (size_t)2048 * 2048 * 2, hipMemcpyDeviceToDevice, stream);
    (void)hipMemcpyAsync(dbg2 + 8 * MiB, ws + WS_A4, (size_t)2048 * 2048 * 2, hipMemcpyDeviceToDevice, stream);
    nv::forward(NI, (float*)d_out, nscr, stream, (1u << 1) | (1u << 2), dbg1);
    hipLaunchKernelGGL(dbg::axpy, dim3(1024), dim3(256), 0, stream, dbg1 + (4u << 20), NI.x, nv::ALPHA, (long)2048 * 2048);
    hipLaunchKernelGGL(dbg::cmp, dim3(1024), dim3(256), 0, stream, (const void*)dbg2, 1, 2048L, 1L, 1.f, (const float*)dbg1, 2048L, 1L, 2048, 2048, acc + 0);
    hipLaunchKernelGGL(dbg::cmp, dim3(1024), dim3(256), 0, stream, (const void*)(dbg2 + 8 * MiB), 1, 2048L, 1L, 1.f, (const float*)dbg1 + (4u << 20), 2048L, 1L, 2048, 2048, acc + 2);
    nchk = DBG_NCHK;
#endif
    hipLaunchKernelGGL(dbg::perturb, dim3(2048), dim3(256), 0, stream, (float*)d_out, (size_t)M * D, (const float*)acc, nchk);
#endif
}
```

```cpp
#define DEBUG_STAGE 0
#include <hip/hip_runtime.h>
#include <cstdio>
#include <cstdint>
namespace pg8 {
#define PG8_LAS __attribute__((address_space(3)))
typedef unsigned short bf16_t;
typedef short bf16x8 __attribute__((ext_vector_type(8)));
typedef float f32x4 __attribute__((ext_vector_type(4)));
typedef float f32x2 __attribute__((ext_vector_type(2)));
typedef unsigned u32x4 __attribute__((ext_vector_type(4)));
typedef unsigned u32x2 __attribute__((ext_vector_type(2)));
constexpr int BM = 256, BK = 64, HALF = 128, HTB = HALF * BK * 2  , STAGE_BYTES = 8 * HTB, NXCD = 8, WGM = 8;

__host__ __device__ __forceinline__ int lds_byte(int r, int c) { const int st = (r >> 4) * 2 + (c >> 5), rr = r & 15, cc = c & 31, ob = rr * 64 + cc * 2; return st * 1024 + (ob ^ (((ob >> 9) & 1) << 5)); }
__host__ __device__ __forceinline__ void stage_rc(int b, int& R, int& C) { const int st = b / 1024, sb = b % 1024, swz = sb ^ (((sb >> 9) & 1) << 5); R = (st >> 1) * 16 + swz / 64; C = (st & 1) * 32 + (swz % 64) / 2; }
__host__ __device__ __forceinline__ int perm32(int rho) { const int n = rho >> 4, i = rho & 15; return 8 * (i >> 2) + 4 * n + (i & 3); }

struct Unit { int pm, pn, z, aux; };
struct Gemm { int lda, ldb, K; };
typedef int i32x4_t __attribute__((ext_vector_type(4)));
typedef int i32x8_t __attribute__((ext_vector_type(8)));
__device__ __forceinline__ i32x8_t cat8(bf16x8 a, bf16x8 b) { return __builtin_shufflevector(__builtin_bit_cast(i32x4_t, a), __builtin_bit_cast(i32x4_t, b), 0, 1, 2, 3, 4, 5, 6, 7); }
template <class S, class = void> struct sched_mode { static constexpr int v = 0; };
template <class S> struct sched_mode<S, decltype((void)S::MODE)> { static constexpr int v = S::MODE; };
__device__ __forceinline__ f32x4 i2f4(f32x4 a) { const i32x4_t i = __builtin_bit_cast(i32x4_t, a); return (f32x4){(float)i[0], (float)i[1], (float)i[2], (float)i[3]}; }

template <int NM, int NN, int ZZ, int MODE_ = 0> struct DenseOrderT {
    static constexpr bool GATHER = false, CARRY = false; static constexpr int MODE = MODE_;
    static constexpr int per_z = NM * NN, nwg = per_z * ZZ;
    const char* A; const char* B; size_t bsA, bsB, tA, tB;
    int G, c;
    __device__ void init(const void* A_, const void* B_, int lda, int ldb, size_t bsA_el, size_t bsB_el, int G_, int c_) {
        A = (const char*)A_; B = (const char*)B_; bsA = bsA_el * 2; bsB = bsB_el * 2; tA = (size_t)BM * lda * 2; tB = (size_t)BM * ldb * 2; G = G_; c = c_; }
    __device__ __forceinline__ bool next(int i, Unit& u) const {
        const int L = i * G + c; if (L >= nwg) return false;
        int wgid = L; { constexpr int q = nwg / NXCD, r = nwg % NXCD; const int xcd = wgid % NXCD, off = wgid / NXCD; wgid = (xcd < r ? xcd * (q + 1) : r * (q + 1) + (xcd - r) * q) + off; }
        u.z = wgid / per_z; wgid -= u.z * per_z;
        constexpr int nig = WGM * NN; const int gid = wgid / nig, fm = gid * WGM, gsz = (NM - fm) < WGM ? (NM - fm) : WGM;
        static_assert(NM % WGM == 0, "row tiles in whole groups of 8");
        u.pm = fm + ((wgid % nig) % WGM); u.pn = (wgid % nig) / WGM; u.aux = 0; (void)gsz; return true;
    }
    __device__ __forceinline__ const char* abase(const Unit& u) const { return A + (size_t)u.z * bsA + (size_t)u.pm * tA; }
    __device__ __forceinline__ const char* bbase(const Unit& u) const { return B + (size_t)u.z * bsB + (size_t)u.pn * tB; }
    __device__ __forceinline__ unsigned arow(const Unit&, int r) const { return (unsigned)r; }
    __device__ __forceinline__ void a_ready(const Unit&) const {}
    __device__ __forceinline__ void done(const Unit&) const {}
};

__device__ __forceinline__ unsigned cvt_pk_bf16(float lo, float hi) { unsigned r; asm volatile("v_cvt_pk_bf16_f32 %0, %1, %2" : "=v"(r) : "v"(lo), "v"(hi)); return r; }
__device__ __forceinline__ float bf_lo(unsigned w) { return __uint_as_float(w << 16); }
__device__ __forceinline__ float bf_hi(unsigned w) { return __uint_as_float(w & 0xffff0000u); }
__device__ __forceinline__ float silu_f(float v) { return v * __builtin_amdgcn_rcpf(1.0f + __builtin_amdgcn_exp2f(-1.44269504f * v)); }

template <int ACT, bool NT = false> struct EpiBf16 {
    static constexpr bool PERM = true;
    bf16_t* O; int ldc; int split_cols; size_t split_stride; float scale0; size_t zstride; float gs = 1.f;
    __device__ __forceinline__ void operator()(const f32x4 (&acc)[2][2][4][2], const Unit& u, int wr, int wc, int fr, int fq) const {
        const int row0 = u.pm * BM + wr * 64 + fr; int colt = u.pn * BM; bf16_t* base = O + (size_t)u.z * zstride;
        float sc = gs; if (split_cols) { const int t = colt / split_cols; base += (size_t)t * split_stride; colt -= t * split_cols; if (t == 0) sc = scale0 * gs; }
        const int col0 = colt + wc * 32 + 8 * fq;
#pragma unroll
        for (int ai = 0; ai < 2; ++ai)
#pragma unroll
            for (int m = 0; m < 4; ++m) { bf16_t* rowp = base + (size_t)(row0 + ai * HALF + m * 16) * ldc + col0;
#pragma unroll
                for (int bj = 0; bj < 2; ++bj) { f32x4 v0 = acc[ai][bj][m][0], v1 = acc[ai][bj][m][1];
                    if (ACT == 3) {
#pragma unroll
                        for (int j = 0; j < 4; ++j) { v0[j] = silu_f(v0[j]); v1[j] = silu_f(v1[j]); } }
                    v0 = v0 * sc; v1 = v1 * sc; u32x4 w; w.x = cvt_pk_bf16(v0[0], v0[1]); w.y = cvt_pk_bf16(v0[2], v0[3]); w.z = cvt_pk_bf16(v1[0], v1[1]); w.w = cvt_pk_bf16(v1[2], v1[3]);
                    if (NT) __builtin_nontemporal_store(w, (u32x4*)(rowp + bj * HALF)); else *(u32x4*)(rowp + bj * HALF) = w; } }
    }
};

template <class Epi, class Sched, bool ALIGN_EPI>
__device__ __forceinline__ void gemm_phase(PG8_LAS unsigned char* lds, const Gemm g, const Sched& S, const Epi& E) {
    int tid_ = threadIdx.x; asm volatile("" : "+v"(tid_));
    const int tid = tid_, wid = __builtin_amdgcn_readfirstlane(tid >> 6), lane = tid & 63, wr = wid >> 2, wc = wid & 3, fr = lane & 15, fq = lane >> 4;
    const int K = g.K, nt = K / BK;
    int Rr[2], Cc[2]; unsigned voffB[2];
#pragma unroll
    for (int i = 0; i < 2; ++i) { int R, C; stage_rc(tid * 16 + i * 8192, R, C); const int Rb = Epi::PERM ? ((R & ~31) + perm32(R & 31)) : R; Rr[i] = R; Cc[i] = C; voffB[i] = (unsigned)(Rb * g.ldb + C) * 2u; }
    const size_t kstep = (size_t)(BK * 2);
    const size_t hstepB = (size_t)HALF * g.ldb * 2;
    const unsigned ldsw = (unsigned)wid * 1024u;
    const int aoff = lds_byte(wr * 64 + fr, fq * 8), boff = lds_byte(wc * 32 + fr, fq * 8);
#define PG8_SA(b, h) (((b) * 2 + (h)) * HTB)
#define PG8_SB(b, h) ((4 + (b) * 2 + (h)) * HTB)
#define PG8_STAGE2(bufoff, gbase, v0, v1) do { \
        __builtin_amdgcn_global_load_lds((const unsigned*)((const char*)(gbase) + (v0)), (PG8_LAS unsigned*)(lds + (bufoff) + ldsw), 16, 0, 0); \
        __builtin_amdgcn_global_load_lds((const unsigned*)((const char*)(gbase) + (v1)), (PG8_LAS unsigned*)(lds + (bufoff) + ldsw + 8192), 16, 0, 0); } while (0)
#define PG8_STAGEB(bufoff, gbase) PG8_STAGE2(bufoff, gbase, voffB[0], voffB[1])
#define PG8_STAGEA_C(bufoff, gbase, h) PG8_STAGE2(bufoff, gbase, vAc[h][0], vAc[h][1])
#define PG8_STAGEA_X(bufoff, gbase, h) PG8_STAGE2(bufoff, gbase, (last ? vAn[h][0] : vAc[h][0]), (last ? vAn[h][1] : vAc[h][1]))
#define PG8_LDA(dst, b, h) do { _Pragma("unroll") for (int m = 0; m < 4; ++m) _Pragma("unroll") for (int k = 0; k < 2; ++k) dst[m][k] = *(const PG8_LAS bf16x8*)(lds + PG8_SA(b, h) + aoff + m * 2048 + k * 1024); } while (0)
#define PG8_LDB(dst, b, h) do { _Pragma("unroll") for (int n = 0; n < 2; ++n) _Pragma("unroll") for (int k = 0; k < 2; ++k) dst[n][k] = *(const PG8_LAS bf16x8*)(lds + PG8_SB(b, h) + boff + n * 2048 + k * 1024); } while (0)
#define PG8_MMA(ai, bj, At, Bt) do { __builtin_amdgcn_s_setprio(1); \
        if constexpr (sched_mode<Sched>::v == 2) { _Pragma("unroll") for (int m = 0; m < 4; ++m) _Pragma("unroll") for (int n = 0; n < 2; ++n) _Pragma("unroll") for (int k = 0; k < 2; ++k) \
            acc[ai][bj][m][n] = __builtin_bit_cast(f32x4, __builtin_amdgcn_mfma_i32_16x16x64_i8(__builtin_bit_cast(i32x4_t, Bt[n][k]), __builtin_bit_cast(i32x4_t, At[m][k]), __builtin_bit_cast(i32x4_t, acc[ai][bj][m][n]), 0, 0, 0)); } \
        else if constexpr (sched_mode<Sched>::v == 1) { _Pragma("unroll") for (int m = 0; m < 4; ++m) _Pragma("unroll") for (int n = 0; n < 2; ++n) \
            asm volatile("v_mfma_scale_f32_16x16x128_f8f6f4 %0, %1, %2, %0, %3, %3 op_sel_hi:[0,0,0]" : "+v"(acc[ai][bj][m][n]) : "v"(cat8(Bt[n][0], Bt[n][1])), "v"(cat8(At[m][0], At[m][1])), "v"(f8one)); } \
        else { _Pragma("unroll") for (int m = 0; m < 4; ++m) _Pragma("unroll") for (int n = 0; n < 2; ++n) _Pragma("unroll") for (int k = 0; k < 2; ++k) \
            acc[ai][bj][m][n] = __builtin_amdgcn_mfma_f32_16x16x32_bf16(Bt[n][k], At[m][k], acc[ai][bj][m][n], 0, 0, 0); } \
        __builtin_amdgcn_s_setprio(0); } while (0)
#define PG8_WAIT_V(n) asm volatile("s_waitcnt vmcnt(" #n ")" ::: "memory")
#define PG8_WAIT_L(n) asm volatile("s_waitcnt lgkmcnt(" #n ")" ::: "memory")
#define PG8_BAR __builtin_amdgcn_s_barrier()
#define PG8_SCHED __builtin_amdgcn_sched_barrier(0)
#define PG8_AOFFS(dst, u) do { _Pragma("unroll") for (int h = 0; h < 2; ++h) _Pragma("unroll") for (int i = 0; i < 2; ++i) dst[h][i] = (S.arow(u, h * HALF + Rr[i]) * (unsigned)g.lda + (unsigned)Cc[i]) * 2u; } while (0)
    Unit cur, nxt; int ui = 0;
    const int f8one = 0x7f7f7f7f; (void)f8one;
    if (!S.next(0, cur)) return;
    f32x4 acc[2][2][4][2];
#pragma unroll
    for (int a = 0; a < 2; ++a)
#pragma unroll
        for (int b = 0; b < 2; ++b)
#pragma unroll
            for (int m = 0; m < 4; ++m)
#pragma unroll
                for (int n = 0; n < 2; ++n) acc[a][b][m][n] = (f32x4){0.f, 0.f, 0.f, 0.f};
    bf16x8 At[4][2], B0[2][2], B1[2][2];
    unsigned vAc[2][2], vAn[2][2];
    PG8_AOFFS(vAc, cur);
    const char* cA = S.abase(cur); const char* cB = S.bbase(cur);
    S.a_ready(cur);
    PG8_STAGEB(PG8_SB(0, 0), cB); PG8_STAGEB(PG8_SB(0, 1), cB + hstepB); PG8_STAGEA_C(PG8_SA(0, 0), cA, 0); PG8_STAGEA_C(PG8_SA(0, 1), cA, 1);
    if (wr == 1) PG8_BAR;
    PG8_WAIT_V(2); PG8_BAR;
    PG8_STAGEB(PG8_SB(1, 0), cB + kstep); PG8_STAGEA_C(PG8_SA(1, 0), cA + kstep, 0); PG8_STAGEB(PG8_SB(1, 1), cB + hstepB + kstep);
    PG8_WAIT_V(6); PG8_BAR;
    for (;;) {
        const bool has_next = S.next(ui + 1, nxt);
        const char* nA = cA; const char* nB = cB;
        if (has_next) { nA = S.abase(nxt); nB = S.bbase(nxt); PG8_AOFFS(vAn, nxt); }
        else {
#pragma unroll
            for (int h = 0; h < 2; ++h)
#pragma unroll
                for (int i = 0; i < 2; ++i) vAn[h][i] = vAc[h][i]; }
#pragma nounroll
        for (int t = 0; t < nt; t += 2) {
            const bool last = (t == nt - 2);
            const char* a1 = cA + (size_t)(t + 1) * kstep;
            const char* a2 = last ? nA : cA + (size_t)(t + 2) * kstep; const char* b2 = last ? nB : cB + (size_t)(t + 2) * kstep;
            const char* a3 = a2 + kstep; const char* b3 = b2 + kstep;
            if (last && has_next) S.a_ready(nxt);
            PG8_LDB(B0, 0, 0); PG8_LDB(B1, 0, 1); PG8_SCHED; PG8_LDA(At, 0, 0); PG8_STAGEA_C(PG8_SA(1, 1), a1, 1);
            PG8_WAIT_V(8); PG8_WAIT_L(0); PG8_BAR; PG8_MMA(0, 0, At, B0); PG8_MMA(0, 1, At, B1); PG8_BAR; PG8_SCHED;
            PG8_LDA(At, 0, 1); PG8_STAGEB(PG8_SB(0, 0), b2); PG8_STAGEB(PG8_SB(0, 1), b2 + hstepB); PG8_STAGEA_X(PG8_SA(0, 0), a2, 0);
            PG8_WAIT_V(8); PG8_WAIT_L(0); PG8_BAR; PG8_MMA(1, 0, At, B0); PG8_MMA(1, 1, At, B1); PG8_BAR; PG8_SCHED;
            PG8_LDB(B0, 1, 0); PG8_LDB(B1, 1, 1); PG8_SCHED; PG8_LDA(At, 1, 0); PG8_STAGEA_X(PG8_SA(0, 1), a2, 1);
            PG8_WAIT_V(8); PG8_WAIT_L(0); PG8_BAR; PG8_MMA(0, 0, At, B0); PG8_MMA(0, 1, At, B1); PG8_BAR; PG8_SCHED;
            PG8_LDA(At, 1, 1); PG8_STAGEB(PG8_SB(1, 0), b3); PG8_STAGEB(PG8_SB(1, 1), b3 + hstepB); PG8_STAGEA_X(PG8_SA(1, 0), a3, 0);
            PG8_WAIT_V(8); PG8_WAIT_L(0); PG8_BAR; PG8_MMA(1, 0, At, B0); PG8_MMA(1, 1, At, B1); PG8_BAR; PG8_SCHED;
        }
        if constexpr (sched_mode<Sched>::v == 1) asm volatile("s_nop 15\n\ts_nop 15" ::: "memory");
        if constexpr (ALIGN_EPI) { if (wr == 0) PG8_BAR; }
        E(acc, cur, wr, wc, fr, fq); S.done(cur);
        if (!has_next) break;
#pragma unroll
        for (int a = 0; a < 2; ++a)
#pragma unroll
            for (int m = 0; m < 4; ++m) { float cf = 0.f; if constexpr (Sched::CARRY) cf = S.carry(cur, nxt, a * HALF + wr * 64 + m * 16 + fr);
#pragma unroll
                for (int b = 0; b < 2; ++b)
#pragma unroll
                    for (int n = 0; n < 2; ++n) { if constexpr (Sched::CARRY) acc[a][b][m][n] = acc[a][b][m][n] * cf; else acc[a][b][m][n] = (f32x4){0.f, 0.f, 0.f, 0.f}; } }
        cur = nxt; cA = nA; cB = nB; ++ui;
#pragma unroll
        for (int h = 0; h < 2; ++h)
#pragma unroll
            for (int i = 0; i < 2; ++i) vAc[h][i] = vAn[h][i];
        if constexpr (ALIGN_EPI) { if (wr == 1) PG8_BAR; }
    }
    PG8_WAIT_V(0);
    if constexpr (!ALIGN_EPI) { if (wr == 0) PG8_BAR; }
    PG8_BAR;
#undef PG8_SA
#undef PG8_SB
#undef PG8_STAGE2
#undef PG8_STAGEB
#undef PG8_STAGEA_C
#undef PG8_STAGEA_X
#undef PG8_LDA
#undef PG8_LDB
#undef PG8_MMA
#undef PG8_WAIT_V
#undef PG8_WAIT_L
#undef PG8_BAR
#undef PG8_SCHED
#undef PG8_AOFFS
}
}
#define GAS __attribute__((address_space(1)))
#define LAS __attribute__((address_space(3)))
typedef unsigned short bf16;
typedef unsigned v4u __attribute__((ext_vector_type(4)));
typedef float f32x4 __attribute__((ext_vector_type(4)));
typedef short bf16x8 __attribute__((ext_vector_type(8)));
typedef GAS unsigned gu32;
typedef GAS unsigned long long gu64;
#define RLX_AGENT __ATOMIC_RELAXED, __HIP_MEMORY_SCOPE_AGENT
#define LDS_WAIT() asm volatile("s_waitcnt lgkmcnt(0)" ::: "memory")
#define VM_WAIT() asm volatile("s_waitcnt vmcnt(0)" ::: "memory")
__device__ __forceinline__ unsigned long long rt() { return __builtin_amdgcn_s_memrealtime(); }
__device__ __forceinline__ unsigned f2bf(float f) { unsigned u = __builtin_bit_cast(unsigned, f); return (u + 0x7fffu + ((u >> 16) & 1u)) >> 16; }
__device__ __forceinline__ unsigned pk2(float lo, float hi) { return f2bf(lo) | (f2bf(hi) << 16); }

#define XB_TMO      128
#define XB_XCNT(j)  (256  + 64 * (j))
#define XB_XSUB(j)  (1280 + 64 * (j))
#define XB_XGEN(j)  (2304 + 64 * (j))
#define XB_TOP      3328
#define XB_TOPGEN   3392
#define XCD_BAR_WORDS 3456
#define XB_SPIN_CAP (1u << 18)

__device__ __forceinline__ unsigned xb_ld(unsigned* p)              { return __hip_atomic_load(p, __ATOMIC_RELAXED, __HIP_MEMORY_SCOPE_AGENT); }
__device__ __forceinline__ unsigned xb_add(unsigned* p, unsigned v) { return __hip_atomic_fetch_add(p, v, __ATOMIC_RELAXED, __HIP_MEMORY_SCOPE_AGENT); }
__device__ __forceinline__ unsigned xb_xcc_id() { return (unsigned)__builtin_amdgcn_s_getreg((3 << 11) | 20) & 0xFu; }
#define XB_SPIN(cond, bar) do { unsigned _sp = 0; while (cond) { __builtin_amdgcn_s_sleep(1); \
    if ((++_sp & 255u) == 0u) { if (xb_ld(&(bar)[XB_TMO])) break; if (_sp > XB_SPIN_CAP) { atomicAdd(&(bar)[XB_TMO], 1u); break; } } } } while (0)

struct XcdBarrier {
    unsigned* bar; unsigned x;
    volatile LAS unsigned* st;
};

__device__ __forceinline__ XcdBarrier xcd_barrier_post(unsigned* bar, volatile LAS unsigned* st) {
    XcdBarrier b; b.bar = bar; b.x = xb_xcc_id(); b.st = st;
    if (threadIdx.x == 0) (void)xb_add(&bar[XB_XCNT(b.x)], 1u);
    return b;
}
__device__ __forceinline__ void xcd_barrier_complete(unsigned* bar, unsigned x, unsigned& nloc, unsigned& nx) {
    const unsigned G = gridDim.x * gridDim.y * gridDim.z;
    unsigned sum, cnt, mine, sp = 0u;
    for (;;) {
        sum = 0u; cnt = 0u; mine = 0u;
#pragma unroll
        for (unsigned j = 0; j < 16; ++j) { const unsigned c = xb_ld(&bar[XB_XCNT(j)]); sum += c; cnt += (c > 0u) ? 1u : 0u; mine = (j == x) ? c : mine; }
        if (sum == G) break;
        __builtin_amdgcn_s_sleep(1);
        if ((++sp & 255u) == 0u) { if (xb_ld(&bar[XB_TMO])) break; if (sp > XB_SPIN_CAP) { atomicAdd(&bar[XB_TMO], 1u); break; } }
    }
    nloc = mine > 0u ? mine : 1u; nx = cnt > 0u ? cnt : 1u;
}

__device__ __forceinline__ void xcd_barrier(const XcdBarrier& b) {
    asm volatile("s_waitcnt vmcnt(0)" ::: "memory");
    __syncthreads();
    if (threadIdx.x == 0) {
        unsigned* bar = b.bar;
        __builtin_amdgcn_s_waitcnt(0);
        unsigned nloc = b.st[0], nx = b.st[1];
        if (nloc == 0u) { xcd_barrier_complete(bar, b.x, nloc, nx); b.st[0] = nloc; b.st[1] = nx; }
        const unsigned old = xb_add(&bar[XB_XSUB(b.x)], 1u);
        const unsigned gen = old / nloc;
        if (old + 1u == (gen + 1u) * nloc) {
            __builtin_amdgcn_fence(__ATOMIC_RELEASE, "agent");
            asm volatile("s_waitcnt vmcnt(0)" ::: "memory");
            const unsigned og = xb_add(&bar[XB_TOP], 1u);
            const unsigned tg = og / nx;
            if (og + 1u == (tg + 1u) * nx) xb_add(&bar[XB_TOPGEN], 1u);
            else XB_SPIN(xb_ld(&bar[XB_TOPGEN]) == tg, bar);
            __builtin_amdgcn_fence(__ATOMIC_ACQUIRE, "agent");
            xb_add(&bar[XB_XGEN(b.x)], 1u);
            asm volatile("s_waitcnt vmcnt(0)" ::: "memory");
        } else {
            XB_SPIN(xb_ld(&bar[XB_XGEN(b.x)]) == gen, bar);
            __builtin_amdgcn_fence(__ATOMIC_ACQUIRE, "agent");
            asm volatile("s_waitcnt vmcnt(0)" ::: "memory");
        }
    }
    __syncthreads();
}

#ifndef REPEAT_MASK
#define REPEAT_MASK 0u
#endif
constexpr int NWAVES = 8;
constexpr int BATCH = 8, SEQ = 2048, D = 2048, M = BATCH * SEQ;
constexpr int NHA = 16, DHA = 128, GW = 64, GROWS = 32;
constexpr int RH = 8, RQK = 256, RV = 512, RVW = 4096, RPROJ = 12288;
constexpr int NEXP = 32, FF = 512;
constexpr float ALPHA = 1.41421356237309515f, LN_EPS = 1e-5f, GN_EPS = 1e-6f;
constexpr size_t MiB = 1u << 20;
constexpr size_t WS_CTL = 0, CTL_ZERO_BYTES = 2 * MiB;
constexpr size_t WS_TAB = 2 * MiB;
constexpr size_t WS_ROTD = WS_TAB + 3 * MiB + 4096;
constexpr size_t WS_SX = WS_TAB + 4 * MiB;
constexpr size_t WS_X2I8 = 8 * MiB;
constexpr size_t WS_WAIN = 8 * MiB, WS_WAOUT = 32 * MiB, WS_WRIN = 40 * MiB, WS_WROUT = 88 * MiB, WS_WM1 = 104 * MiB, WS_WM2 = 232 * MiB;
constexpr size_t WS_A0 = 296 * MiB, WS_A1 = 360 * MiB, WS_A2 = 424 * MiB, WS_A3 = 488 * MiB, WS_A4 = 552 * MiB, WS_A5 = 616 * MiB, WS_A6 = 744 * MiB, WS_MISC = 872 * MiB, WS_FAST_END = 1008 * MiB;
constexpr size_t WS_DBG1 = 888 * MiB, WS_DBG2 = 984 * MiB, WS_END = 1080 * MiB;
constexpr size_t WS_PB1 = 880 * MiB;
constexpr int CW_TMO = 0, CW_CODE = 1;
constexpr int CW_DBG = 64;
constexpr int CW_BAR = 4096;
constexpr int CW_CNT = 8192;
constexpr int CW_FSC = 16384;
constexpr int CW_STATS = 65536;
static_assert((CW_STATS + 4 * 2 * 16384) * 4 <= (int)CTL_ZERO_BYTES, "CTL words inside the memset region");
constexpr int RING_OFF = 0, RING_BYTES = 131072;
constexpr int LDSCTL_OFF = RING_BYTES, MISC_OFF = LDSCTL_OFF + 320;
constexpr int LDS_BYTES = 147456;
static_assert(MISC_OFF + 128 <= LDS_BYTES, "LDS map");
struct Ins; struct Frame;
__device__ __forceinline__ void build_router_frags(const Ins& I, Frame& F);
__device__ __forceinline__ void build_decay_table(const Ins& I, Frame& F);
typedef unsigned short bf16;
struct Frame {
    LAS unsigned char* lds;
    volatile LAS unsigned* MISC;
    gu32* ctl;
    int tid, lane, wave;
    int vcu, G;
    unsigned char* ws;
};
__device__ __forceinline__ float wave_sum(float v) {
#pragma unroll
    for (int o = 1; o < 64; o <<= 1) v += __shfl_xor(v, o);
    return v;
}
__device__ __forceinline__ void tr_item(const float* W, int ldw, int k0, int n0, bf16* WT, int ldt, int drow0, LAS float* scr, int lane) {
    f32x4 v[8];
#pragma unroll
    for (int i = 0; i < 8; ++i) v[i] = __builtin_nontemporal_load((const GAS f32x4*)(W + (size_t)(k0 + (lane >> 3) + 8 * i) * ldw + n0 + (lane & 7) * 4));
#pragma unroll
    for (int i = 0; i < 8; ++i) { LAS float* d = scr + ((lane >> 3) + 8 * i) * 33 + (lane & 7) * 4; d[0] = v[i].x; d[1] = v[i].y; d[2] = v[i].z; d[3] = v[i].w; }
    LDS_WAIT(); asm volatile("" ::: "memory");
    const int c = lane & 7;
#pragma unroll
    for (int j = 0; j < 4; ++j) { const int n = (lane >> 3) + 8 * j; const LAS float* s = scr + (8 * c) * 33 + n;
        v4u o; o.x = pk2(s[0 * 33], s[1 * 33]); o.y = pk2(s[2 * 33], s[3 * 33]); o.z = pk2(s[4 * 33], s[5 * 33]); o.w = pk2(s[6 * 33], s[7 * 33]);
        __builtin_nontemporal_store(o, (GAS v4u*)(WT + (size_t)(drow0 + n) * ldt + k0 + 8 * c)); }
    LDS_WAIT(); asm volatile("" ::: "memory");
}
__device__ __forceinline__ unsigned pk4_fp8(float a, float b, float c, float d) {
    a = __builtin_fminf(__builtin_fmaxf(a, -448.f), 448.f); b = __builtin_fminf(__builtin_fmaxf(b, -448.f), 448.f); c = __builtin_fminf(__builtin_fmaxf(c, -448.f), 448.f); d = __builtin_fminf(__builtin_fmaxf(d, -448.f), 448.f);
    int w = 0; w = __builtin_amdgcn_cvt_pk_fp8_f32(a, b, w, false); w = __builtin_amdgcn_cvt_pk_fp8_f32(c, d, w, true); return (unsigned)w; }
__device__ __forceinline__ unsigned pk4_i8(float a, float b, float c, float d) {
    const int ia = (int)__builtin_rintf(__builtin_fminf(__builtin_fmaxf(a, -127.f), 127.f)), ib = (int)__builtin_rintf(__builtin_fminf(__builtin_fmaxf(b, -127.f), 127.f));
    const int ic = (int)__builtin_rintf(__builtin_fminf(__builtin_fmaxf(c, -127.f), 127.f)), id = (int)__builtin_rintf(__builtin_fminf(__builtin_fmaxf(d, -127.f), 127.f));
    return ((unsigned)ia & 255u) | (((unsigned)ib & 255u) << 8) | (((unsigned)ic & 255u) << 16) | ((unsigned)id << 24); }
template <bool I8 = false>
__device__ __forceinline__ void tr_item8(const float* W, int ldw, int k0, int n0, unsigned char* WT, int ldt, int drow0, LAS float* scr, int lane, float mul) {
    f32x4 v[8];
#pragma unroll
    for (int i = 0; i < 8; ++i) v[i] = __builtin_nontemporal_load((const GAS f32x4*)(W + (size_t)(k0 + (lane >> 3) + 8 * i) * ldw + n0 + (lane & 7) * 4));
#pragma unroll
    for (int i = 0; i < 8; ++i) { LAS float* d = scr + ((lane >> 3) + 8 * i) * 33 + (lane & 7) * 4; d[0] = v[i].x * mul; d[1] = v[i].y * mul; d[2] = v[i].z * mul; d[3] = v[i].w * mul; }
    LDS_WAIT(); asm volatile("" ::: "memory");
#pragma unroll
    for (int j = 0; j < 2; ++j) { const int task = lane + 64 * j, n = task >> 2, c = task & 3; const LAS float* s = scr + (16 * c) * 33 + n;
        v4u o;
        if (I8) { o.x = pk4_i8(s[0 * 33], s[1 * 33], s[2 * 33], s[3 * 33]); o.y = pk4_i8(s[4 * 33], s[5 * 33], s[6 * 33], s[7 * 33]); o.z = pk4_i8(s[8 * 33], s[9 * 33], s[10 * 33], s[11 * 33]); o.w = pk4_i8(s[12 * 33], s[13 * 33], s[14 * 33], s[15 * 33]); }
        else { o.x = pk4_fp8(s[0 * 33], s[1 * 33], s[2 * 33], s[3 * 33]); o.y = pk4_fp8(s[4 * 33], s[5 * 33], s[6 * 33], s[7 * 33]); o.z = pk4_fp8(s[8 * 33], s[9 * 33], s[10 * 33], s[11 * 33]); o.w = pk4_fp8(s[12 * 33], s[13 * 33], s[14 * 33], s[15 * 33]); }
        __builtin_nontemporal_store(o, (GAS v4u*)(WT + (size_t)(drow0 + n) * ldt + k0 + 16 * c)); }
    LDS_WAIT(); asm volatile("" ::: "memory");
}
struct Ins { const float *x, *awin, *awout, *rpb, *rwin, *rwout, *dfw, *dbw, *wgr, *bgr, *wer, *ber, *wgate, *wup, *wdown, *lng, *lnb; };

__device__ __forceinline__ float fsc_mul(const Frame& F, int layer, int kind) { const int s = ((const GAS int*)F.ctl)[CW_FSC + layer * 2 + kind]; return __uint_as_float((unsigned)(127 + s) << 23); }
__device__ __forceinline__ void conv_moe_item(const Ins& I, Frame& F, int layer, int r, LAS float* scr) {
    const size_t MW = (size_t)NEXP * D * FF; unsigned char* W1 = F.ws + WS_WM1; unsigned char* W2 = F.ws + WS_WM2;
    if (r < 32768) { const int up = r >= 16384; const int q = r & 16383; const int E = q >> 9, kb = (q & 511) >> 4, nb = q & 15, n0 = nb * 32;
        const float* W = (up ? I.wup : I.wgate) + (size_t)layer * MW + (size_t)E * D * FF;
        tr_item8(W, FF, kb * 64, n0, W1 + (size_t)E * 1024 * D, D, 256 * (n0 >> 7) + (n0 & 127) + (up ? 128 : 0), scr, F.lane, fsc_mul(F, layer, 0)); return; }
    r -= 32768;
    { const int E = r >> 9, kb = (r & 511) >> 6, nb = r & 63, n0 = nb * 32;
        const float* W = I.wdown + (size_t)layer * MW + (size_t)E * FF * D;
        tr_item8(W, D, kb * 64, n0, W2 + (size_t)E * D * FF, FF, n0, scr, F.lane, fsc_mul(F, layer, 1)); }
}
__device__ __forceinline__ float sample_absmax(const float* T0, const float* T1, int ld, int c0, int width, int rows, Frame& F) {
    float sv[2][16]; float mx = 0.f; const size_t n = (size_t)rows * width;
#pragma unroll
    for (int j = 0; j < 16; ++j) { const size_t p = ((size_t)(F.tid * 16 + j) * 4099u) % n; const size_t q = (p / width) * ld + c0 + (p % width); sv[0][j] = T0[q]; sv[1][j] = T1[q]; }
#pragma unroll
    for (int j = 0; j < 16; ++j) mx = __builtin_fmaxf(mx, __builtin_fmaxf(__builtin_fabsf(sv[0][j]), __builtin_fabsf(sv[1][j])));
#pragma unroll
    for (int o = 1; o < 64; o <<= 1) mx = __builtin_fmaxf(mx, __shfl_xor(mx, o));
    LAS float* red = (LAS float*)(F.lds + RING_OFF);
    if (F.lane == 0) red[F.wave] = mx;
    __syncthreads();
    float m = 0.f;
#pragma unroll
    for (int w = 0; w < NWAVES; ++w) m = __builtin_fmaxf(m, red[w]);
    __syncthreads();
    return m;
}
__device__ __forceinline__ int sample_scale_exp(const float* T0, const float* T1, size_t n, Frame& F) {
    const float m = sample_absmax(T0, T1, 4096, 0, 4096, (int)(n / 4096), F);
    int s = 0; if (m > 0.f && m < 3.0e38f) { s = (int)floorf(log2f(28.0f / m)); s = s < -60 ? -60 : (s > 60 ? 60 : s); }
    return s;
}
__device__ __forceinline__ void moe_scale_estimate(const Ins& I, Frame& F) {
    if (blockIdx.x == 4) { const int s = sample_scale_exp(I.rwout, I.rwout, (size_t)RVW * D, F); if (F.tid == 0) ((GAS int*)F.ctl)[CW_FSC + 6] = s; return; }
    if (blockIdx.x >= 5 && blockIdx.x < 8) { const int part = blockIdx.x - 5;
        float m = 1.25f * sample_absmax(I.rwin, I.rwin, RPROJ, part == 0 ? 0 : 4096 * part, 4096, D, F); if (!(m > 0.f && m < 3.0e38f)) m = 1.f;
        if (F.tid == 0) ((GAS float*)F.ctl)[CW_FSC + 8 + part] = m; return; }
    if (blockIdx.x >= 4) return;
    const int layer = blockIdx.x >> 1, kind = blockIdx.x & 1; const size_t MW = (size_t)NEXP * D * FF;
    const int s = sample_scale_exp((kind ? I.wdown : I.wgate) + (size_t)layer * MW, (kind ? I.wdown : I.wup) + (size_t)layer * MW, MW, F);
    if (F.tid == 0) ((GAS int*)F.ctl)[CW_FSC + layer * 2 + kind] = s;
}
constexpr int MOE_ITEMS = 49152;

__device__ __forceinline__ void conv_ret(const Ins& I, Frame& F) {
    LAS float* scr = (LAS float*)(F.lds + RING_OFF + F.wave * 16384);
    constexpr int I_RIN = 32 * 384, I_ROUT = 64 * 64;
    for (int it = F.vcu * NWAVES + F.wave; it < I_RIN + I_ROUT; it += F.G * NWAVES) {
        int r = it;
        if (r < I_RIN) { const int kb = r / 384, nb = r % 384, n0 = nb * 32; const int dr = n0 < 4096 ? n0 : (n0 < 8192 ? n0 + 4096 : n0 - 4096);
            const float wm = ((const GAS float*)F.ctl)[CW_FSC + 8 + (n0 < 4096 ? 0 : (n0 < 8192 ? 1 : 2))];
            tr_item8<true>(I.rwin, RPROJ, kb * 64, n0, F.ws + WS_WRIN, D, dr, scr, F.lane, 127.f / wm); continue; } r -= I_RIN;
        { const int kb = r / 64, nb = r % 64; tr_item8(I.rwout, D, kb * 64, nb * 32, F.ws + WS_WROUT, RVW, nb * 32, scr, F.lane, fsc_mul(F, 3, 0)); }
    }
    __syncthreads();
}
__device__ __forceinline__ void conv_l1(const Ins& I, Frame& F, int lo, int hi) {
    LAS float* scr = (LAS float*)(F.lds + RING_OFF + F.wave * 16384);
    for (int it = lo + F.vcu * NWAVES + F.wave; it < hi; it += F.G * NWAVES) conv_moe_item(I, F, 1, it, scr);
    __syncthreads();
}
__device__ __forceinline__ void conv_l0(const Ins& I, Frame& F, int lo, int hi) {
    LAS float* scr = (LAS float*)(F.lds + RING_OFF + F.wave * 16384);
    for (int it = lo + F.vcu * NWAVES + F.wave; it < hi; it += F.G * NWAVES) conv_moe_item(I, F, 0, it, scr);
    __syncthreads();
}
__device__ __forceinline__ void conv_rest(const Ins& I, Frame& F) {
    conv_l0(I, F, 0, MOE_ITEMS / 2);
    build_router_frags(I, F);
    build_decay_table(I, F);
    float* tc = (float*)(F.ws + WS_TAB); float* tsn = tc + 2048 * 128;
    for (int idx = (F.vcu * NWAVES + F.wave) * 64 + F.lane; idx < 256 * 128; idx += F.G * NWAVES * 64) {
        const int i = idx & 127, r = idx >> 7, t = (r >> 5) * 256 + ((r >> 4) & 1) * 64 + (r & 15);
        const double freq = exp(-(double)i / 128.0 * 9.210340371976184);
        const double ang = (double)t * freq; const double kk = rint(ang * 0.15915494309189535); const double rr = ang - kk * 6.283185307179586;
        tc[t * 128 + i] = (float)cos(rr); tsn[t * 128 + i] = (float)sin(rr);
    }
    if (blockIdx.x == 1 && F.tid < 256) {
        const int i = F.tid & 127; const double freq = exp(-(double)i / 128.0 * 9.210340371976184), ang = (F.tid < 128 ? 16.0 : 128.0) * freq;
        float* rd = (float*)(F.ws + WS_ROTD) + (F.tid < 128 ? 0 : 256);
        rd[i] = (float)cos(ang); rd[128 + i] = (float)sin(ang); }
    __syncthreads();
}
__device__ __forceinline__ void p0_prologue(const Ins& I, Frame& F) {
    moe_scale_estimate(I, F);
    int s_in, s_out;
    { float sv[2][16]; float m0 = 0.f, m1 = 0.f;
#pragma unroll
      for (int j = 0; j < 16; ++j) { const size_t p = (size_t)(F.tid * 16 + j) * 4099u; sv[0][j] = I.awin[p % ((size_t)D * 6144)]; sv[1][j] = I.awout[p % ((size_t)D * D)]; }
#pragma unroll
      for (int j = 0; j < 16; ++j) { m0 = __builtin_fmaxf(m0, __builtin_fabsf(sv[0][j])); m1 = __builtin_fmaxf(m1, __builtin_fabsf(sv[1][j])); }
#pragma unroll
      for (int o = 1; o < 64; o <<= 1) { m0 = __builtin_fmaxf(m0, __shfl_xor(m0, o)); m1 = __builtin_fmaxf(m1, __shfl_xor(m1, o)); }
      LAS float* red = (LAS float*)(F.lds + RING_OFF);
      if (F.lane == 0) { red[F.wave] = m0; red[8 + F.wave] = m1; }
      __syncthreads();
#pragma unroll
      for (int w = 0; w < NWAVES; ++w) { m0 = __builtin_fmaxf(m0, red[w]); m1 = __builtin_fmaxf(m1, red[8 + w]); }
      __syncthreads();
      s_in = 0; if (m0 > 0.f && m0 < 3.0e38f) { s_in = (int)floorf(log2f(28.0f / m0)); s_in = s_in < -60 ? -60 : (s_in > 60 ? 60 : s_in); }
      s_out = 0; if (m1 > 0.f && m1 < 3.0e38f) { s_out = (int)floorf(log2f(28.0f / m1)); s_out = s_out < -60 ? -60 : (s_out > 60 ? 60 : s_out); } }
    if (blockIdx.x == 0 && F.tid == 0) { ((GAS int*)F.ctl)[CW_FSC + 4] = s_in; ((GAS int*)F.ctl)[CW_FSC + 5] = s_out; }
    const float m_in = __uint_as_float((unsigned)(127 + s_in) << 23), m_out = __uint_as_float((unsigned)(127 + s_out) << 23);
    LAS float* scr = (LAS float*)(F.lds + RING_OFF + F.wave * 16384);
    const int gw = F.vcu * NWAVES + F.wave, NGW = F.G * NWAVES;
    constexpr int I_AIN = 32 * 192, I_AOUT = 32 * 64;
    constexpr int NITEMS = I_AIN + I_AOUT;
    for (int it = gw; it < NITEMS; it += NGW) {
        int r = it;
        if (r < I_AIN) { const int kb = r / 192, nb = r % 192; tr_item8(I.awin, 6144, kb * 64, nb * 32, F.ws + WS_WAIN, D, nb * 32, scr, F.lane, m_in); continue; } r -= I_AIN;
        { const int kb = r / 64, nb = r % 64; tr_item8(I.awout, D, kb * 64, nb * 32, F.ws + WS_WAOUT, D, nb * 32, scr, F.lane, m_out); }
    }
    unsigned char* XF8 = F.ws + WS_A0;
    for (int m = gw; m < M; m += NGW) {
        const GAS f32x4* xr = (const GAS f32x4*)(I.x + (size_t)m * D);
#pragma unroll
        for (int j = 0; j < 2; ++j) { const int ch = F.lane + 64 * j; const f32x4 a = __builtin_nontemporal_load(xr + 4 * ch), b = __builtin_nontemporal_load(xr + 4 * ch + 1), c = __builtin_nontemporal_load(xr + 4 * ch + 2), d = __builtin_nontemporal_load(xr + 4 * ch + 3);
            v4u o; o.x = pk4_fp8(a.x, a.y, a.z, a.w); o.y = pk4_fp8(b.x, b.y, b.z, b.w); o.z = pk4_fp8(c.x, c.y, c.z, c.w); o.w = pk4_fp8(d.x, d.y, d.z, d.w); *(GAS v4u*)(XF8 + (size_t)m * D + 16 * ch) = o; }
    }
}
__device__ __forceinline__ void fp8x4_f32_(unsigned w, float* o) { const pg8::f32x2 lo = __builtin_amdgcn_cvt_pk_f32_fp8((int)w, false), hi = __builtin_amdgcn_cvt_pk_f32_fp8((int)w, true); o[0] = lo.x; o[1] = lo.y; o[2] = hi.x; o[3] = hi.y; }
__device__ __forceinline__ pg8::u32x4 widen8_bf16(unsigned lo, unsigned hi, float sc) {
    float f[8]; fp8x4_f32_(lo, f); fp8x4_f32_(hi, f + 4);
    pg8::u32x4 o; o.x = pg8::cvt_pk_bf16(f[0] * sc, f[1] * sc); o.y = pg8::cvt_pk_bf16(f[2] * sc, f[3] * sc); o.z = pg8::cvt_pk_bf16(f[4] * sc, f[5] * sc); o.w = pg8::cvt_pk_bf16(f[6] * sc, f[7] * sc); return o; }
struct EpiF8 {
    static constexpr bool PERM = true;
    unsigned char* O; int ldc; int split_cols; size_t split_stride; float s0, s1;
    __device__ __forceinline__ void operator()(const pg8::f32x4 (&acc)[2][2][4][2], const pg8::Unit& u, int wr, int wc, int fr, int fq) const {
        using namespace pg8;
        const int row0 = u.pm * BM + wr * 64 + fr; int colt = u.pn * BM; const int t = colt / split_cols; unsigned char* base = O + (size_t)t * split_stride; colt -= t * split_cols;
        const float sc = t == 0 ? s0 : s1; const int col0 = colt + wc * 32 + 8 * fq;
#pragma unroll
        for (int ai = 0; ai < 2; ++ai)
#pragma unroll
            for (int m = 0; m < 4; ++m) { unsigned char* rowp = base + (size_t)(row0 + ai * HALF + m * 16) * ldc + col0;
#pragma unroll
                for (int bj = 0; bj < 2; ++bj) { const f32x4 v0 = acc[ai][bj][m][0] * sc, v1 = acc[ai][bj][m][1] * sc;
                    u32x2 w; w.x = pk4_fp8(v0[0], v0[1], v0[2], v0[3]); w.y = pk4_fp8(v1[0], v1[1], v1[2], v1[3]); *(GAS u32x2*)(rowp + bj * HALF) = w; } }
    }
};
namespace natt {
constexpr float ATT_O_SCALE = 16.0f, ATT_V_SCALE = 4.0f, ATT_Q_SCALE = 0.08838834764831845f;
typedef short bf16x8 __attribute__((ext_vector_type(8)));
typedef float f32x4 __attribute__((ext_vector_type(4)));
typedef unsigned u32x2 __attribute__((ext_vector_type(2)));
typedef unsigned u32x4 __attribute__((ext_vector_type(4)));
constexpr int KROW = 144, VROW = 80, KBUF = 64 * KROW, VBUF = 128 * VROW, BUF = KBUF + VBUF, RPB_OFF = 4 * BUF, LDS_NEED = RPB_OFF + 2048;
constexpr float ATT_P_SCALE = 256.0f;
typedef int i32x4 __attribute__((ext_vector_type(4)));
typedef int i32x8 __attribute__((ext_vector_type(8)));
constexpr float LOG2E = 1.4426950408889634f;
__device__ __forceinline__ int clampi(int v, int lo, int hi) { return v < lo ? lo : (v > hi ? hi : v); }
__device__ __forceinline__ void attn_phase(LAS unsigned char* lds, const unsigned char* Q, const unsigned char* Kg, const unsigned char* VTg, unsigned char* O, const float* rpb, int G, int vcu) {
    const int tid = threadIdx.x, lane = tid & 63, w = __builtin_amdgcn_readfirstlane(tid >> 6), g = lane >> 4, i = lane & 15;
    LAS float* rpbs = (LAS float*)(lds + RPB_OFF);
    for (int unit = vcu; unit < 2048; unit += G) {
        const int b = unit >> 8, h = (unit >> 4) & 15, rp = unit & 15;
        const int r_w = 2 * rp + (w >> 2), jq = w & 3, qc = 16 * jq + i, cw = clampi(16 * jq - 8, 0, 32);
        const int rs_w = clampi(r_w - 4, 0, 24), kr_lo = clampi(2 * rp - 4, 0, 24), kr_hi = clampi(2 * rp - 3, 0, 24) + 8, cs = clampi(qc - 8, 0, 48);
        const size_t tok0 = (size_t)b * 2048;
        i32x8 qf;
        { const unsigned char* qp = Q + (tok0 + r_w * 64 + qc) * 2048 + h * 128 + 32 * g;
          const i32x4 q0 = *(const GAS i32x4*)qp, q1 = *(const GAS i32x4*)(qp + 16); qf = __builtin_shufflevector(q0, q1, 0, 1, 2, 3, 4, 5, 6, 7); }
        u32x4 kA, vA, kB, vB, kC, vC, kD, vD;
        const unsigned char* kbase = Kg + (tok0 + (tid >> 3)) * 2048 + h * 128 + (tid & 7) * 16;
        const unsigned char* vbase = VTg + ((size_t)b * 2048 + h * 128 + (tid >> 2)) * 2048 + (tid & 3) * 16;
#define NATT_LOAD(kreg, vreg, kr) do { kreg = *(const GAS u32x4*)(kbase + ((size_t)(kr) * 64) * 2048); vreg = *(const GAS u32x4*)(vbase + (kr) * 64); } while (0)
#define NATT_PUT(kreg, vreg, buf) do { *(LAS u32x4*)((buf) + (tid >> 3) * KROW + (tid & 7) * 16) = kreg; *(LAS u32x4*)((buf) + KBUF + (tid >> 2) * VROW + (tid & 3) * 16) = vreg; } while (0)
        __syncthreads();
        if (tid < 480) { const int rr_ = tid >> 5, cc_ = tid & 31; rpbs[tid] = cc_ < 31 ? rpb[h * 465 + rr_ * 31 + cc_] * LOG2E : -1e30f; }
        NATT_LOAD(kA, vA, kr_lo); NATT_LOAD(kB, vB, kr_lo + 1); NATT_LOAD(kC, vC, kr_lo + 2); NATT_LOAD(kD, vD, kr_lo + 3);
        f32x4 o[8];
#pragma unroll
        for (int dt = 0; dt < 8; ++dt) o[dt] = (f32x4){0.f, 0.f, 0.f, 0.f};
        float mrun = -1e30f, lrun = 0.f;
        int bofs[8];
#pragma unroll
        for (int kt = 0; kt < 2; ++kt)
#pragma unroll
            for (int j = 0; j < 4; ++j) { const int kc = cw + 16 * kt + 4 * g + j; bofs[kt * 4 + j] = ((kc >= cs) && (kc < cs + 16)) ? (kc - qc + 15) : 31; }
        int par = 0;
#define NATT_COMPUTE(kr, buf) do { if ((kr) >= rs_w && (kr) < rs_w + 8) { \
                const LAS unsigned char* kb = (buf) + (cw + i) * KROW + 32 * g; \
                f32x4 st[2]; \
                _Pragma("unroll") for (int kt = 0; kt < 2; ++kt) { const i32x4 k0 = *(const LAS i32x4*)(kb + kt * 16 * KROW), k1 = *(const LAS i32x4*)(kb + kt * 16 * KROW + 16); \
                    st[kt] = __builtin_amdgcn_mfma_scale_f32_16x16x128_f8f6f4(__builtin_shufflevector(k0, k1, 0, 1, 2, 3, 4, 5, 6, 7), qf, (f32x4){0.f, 0.f, 0.f, 0.f}, 0, 0, 0, 0x7f7f7f7f, 0, 0x7f7f7f7f); } \
                const int dr = (kr) - r_w + 7; \
                float sc[8]; float mx = -1e30f; \
                _Pragma("unroll") for (int kt = 0; kt < 2; ++kt) \
                    _Pragma("unroll") for (int j = 0; j < 4; ++j) { const float v = st[kt][j] * (LOG2E * ATT_Q_SCALE) + rpbs[dr * 32 + bofs[kt * 4 + j]]; sc[kt * 4 + j] = v; mx = fmaxf(mx, v); } \
                { const u32x2 r16 = __builtin_amdgcn_permlane16_swap(__float_as_uint(mx), __float_as_uint(mx), false, false); mx = fmaxf(mx, fmaxf(__uint_as_float(r16.x), __uint_as_float(r16.y))); \
                  const u32x2 r32 = __builtin_amdgcn_permlane32_swap(__float_as_uint(mx), __float_as_uint(mx), false, false); mx = fmaxf(mx, fmaxf(__uint_as_float(r32.x), __uint_as_float(r32.y))); }     \
                const float mnew = fmaxf(mrun, mx), al = __builtin_amdgcn_exp2f(mrun - mnew); mrun = mnew; \
                float ps = 0.f; \
                const float msh = mnew - 8.0f;                                      \
                _Pragma("unroll") for (int k = 0; k < 8; ++k) { sc[k] = __builtin_amdgcn_exp2f(sc[k] - msh); ps += sc[k]; } \
                lrun = lrun * al + ps; \
                if (__builtin_amdgcn_ballot_w64(al != 1.0f) != 0ull) { _Pragma("unroll") for (int dt = 0; dt < 8; ++dt) o[dt] = o[dt] * al; } \
                int p0 = 0, p1 = 0; p0 = __builtin_amdgcn_cvt_pk_fp8_f32(sc[0], sc[1], p0, false); p0 = __builtin_amdgcn_cvt_pk_fp8_f32(sc[2], sc[3], p0, true);     \
                p1 = __builtin_amdgcn_cvt_pk_fp8_f32(sc[4], sc[5], p1, false); p1 = __builtin_amdgcn_cvt_pk_fp8_f32(sc[6], sc[7], p1, true); \
                const long pf = (long)(((unsigned long)(unsigned)p1 << 32) | (unsigned long)(unsigned)p0); \
                const LAS unsigned char* vb = (buf) + KBUF + i * VROW + (cw + 4 * g); \
                _Pragma("unroll") for (int dt = 0; dt < 8; ++dt) { const unsigned lo = *(const LAS unsigned*)(vb + dt * 16 * VROW), hi = *(const LAS unsigned*)(vb + dt * 16 * VROW + 16); \
                    o[dt] = __builtin_amdgcn_mfma_f32_16x16x32_fp8_fp8((long)(((unsigned long)hi << 32) | (unsigned long)lo), pf, o[dt], 0, 0, 0); } } } while (0)
#define NATT_STEP2(k0, v0, k1, v1, kr) do { if ((kr) < kr_hi) { LAS unsigned char* buf = lds + (2 * par) * BUF; par ^= 1; const bool two = (kr) + 1 < kr_hi; \
                NATT_PUT(k0, v0, buf); if (two) NATT_PUT(k1, v1, buf + BUF); asm volatile("s_waitcnt lgkmcnt(0)" ::: "memory"); __builtin_amdgcn_s_barrier(); asm volatile("" ::: "memory"); \
                if ((kr) + 4 < kr_hi) NATT_LOAD(k0, v0, (kr) + 4); if ((kr) + 5 < kr_hi) NATT_LOAD(k1, v1, (kr) + 5); \
                NATT_COMPUTE(kr, buf); if (two) NATT_COMPUTE((kr) + 1, buf + BUF); } } while (0)
        for (int kr = kr_lo; kr < kr_hi; kr += 4) { NATT_STEP2(kA, vA, kB, vB, kr); NATT_STEP2(kC, vC, kD, vD, kr + 2); }
#undef NATT_STEP2
#undef NATT_COMPUTE
#undef NATT_PUT
        float lt = lrun; lt += __shfl_xor(lt, 16); lt += __shfl_xor(lt, 32);
        const float inv = ATT_O_SCALE / (ATT_V_SCALE * lt);
        unsigned char* op = O + (tok0 + r_w * 64 + qc) * 2048 + h * 128 + 4 * g;
#pragma unroll
        for (int dt = 0; dt < 8; ++dt) *(GAS unsigned*)(op + 16 * dt) = pk4_fp8(o[dt][0] * inv, o[dt][1] * inv, o[dt][2] * inv, o[dt][3] * inv);
#undef NATT_LOAD
    }
}
}

template <bool RES_BF16> struct EpiResStats {
    static constexpr bool PERM = true;
    const void* res; unsigned short* Y; float* part; float gs = 1.f;
    __device__ __forceinline__ void operator()(const pg8::f32x4 (&acc)[2][2][4][2], const pg8::Unit& u, int wr, int wc, int fr, int fq) const {
        using namespace pg8;
        const int row0 = u.pm * BM + wr * 64 + fr, col0 = u.pn * BM + wc * 32 + 8 * fq;
        float s1[2][4], s2[2][4];
#pragma unroll
        for (int ai = 0; ai < 2; ++ai) {
            u32x4 rb[4][2]; f32x4 rf[4][2][2];
#pragma unroll
            for (int m = 0; m < 4; ++m) { const size_t off = (size_t)(row0 + ai * HALF + m * 16) * D + col0;
#pragma unroll
                for (int bj = 0; bj < 2; ++bj) {
                    if (RES_BF16) rb[m][bj] = *(const GAS u32x4*)((const unsigned short*)res + off + bj * HALF);
                    else { rf[m][bj][0] = __builtin_nontemporal_load((const GAS f32x4*)((const float*)res + off + bj * HALF)); rf[m][bj][1] = __builtin_nontemporal_load((const GAS f32x4*)((const float*)res + off + bj * HALF + 4)); } } }
            __builtin_amdgcn_sched_barrier(0);
#pragma unroll
            for (int m = 0; m < 4; ++m) { const size_t off = (size_t)(row0 + ai * HALF + m * 16) * D + col0; float t1 = 0.f, t2 = 0.f;
#pragma unroll
                for (int bj = 0; bj < 2; ++bj) { float r[8];
                    if (RES_BF16) { const u32x4 rw = rb[m][bj];
                        r[0] = bf_lo(rw.x); r[1] = bf_hi(rw.x); r[2] = bf_lo(rw.y); r[3] = bf_hi(rw.y); r[4] = bf_lo(rw.z); r[5] = bf_hi(rw.z); r[6] = bf_lo(rw.w); r[7] = bf_hi(rw.w); }
                    else { const f32x4 a = rf[m][bj][0], b = rf[m][bj][1];
                        r[0] = a.x; r[1] = a.y; r[2] = a.z; r[3] = a.w; r[4] = b.x; r[5] = b.y; r[6] = b.z; r[7] = b.w; }
                    const f32x4 v0 = acc[ai][bj][m][0] * gs, v1 = acc[ai][bj][m][1] * gs;
                    u32x4 w; w.x = cvt_pk_bf16(ALPHA * r[0] + v0[0], ALPHA * r[1] + v0[1]); w.y = cvt_pk_bf16(ALPHA * r[2] + v0[2], ALPHA * r[3] + v0[3]);
                    w.z = cvt_pk_bf16(ALPHA * r[4] + v1[0], ALPHA * r[5] + v1[1]); w.w = cvt_pk_bf16(ALPHA * r[6] + v1[2], ALPHA * r[7] + v1[3]);
                    *(GAS u32x4*)(Y + off + bj * HALF) = w;
                    const float q0 = bf_lo(w.x), q1 = bf_hi(w.x), q2 = bf_lo(w.y), q3 = bf_hi(w.y), q4 = bf_lo(w.z), q5 = bf_hi(w.z), q6 = bf_lo(w.w), q7 = bf_hi(w.w);
                    t1 += ((q0 + q1) + (q2 + q3)) + ((q4 + q5) + (q6 + q7));
                    t2 += ((q0 * q0 + q1 * q1) + (q2 * q2 + q3 * q3)) + ((q4 * q4 + q5 * q5) + (q6 * q6 + q7 * q7)); }
                t1 += __shfl_xor(t1, 16); t1 += __shfl_xor(t1, 32); t2 += __shfl_xor(t2, 16); t2 += __shfl_xor(t2, 32);
                s1[ai][m] = t1; s2[ai][m] = t2; }
        }
#pragma unroll
        for (int ai = 0; ai < 2; ++ai) {
            const float v1 = fq == 0 ? s1[ai][0] : (fq == 1 ? s1[ai][1] : (fq == 2 ? s1[ai][2] : s1[ai][3]));
            const float v2 = fq == 0 ? s2[ai][0] : (fq == 1 ? s2[ai][1] : (fq == 2 ? s2[ai][2] : s2[ai][3]));
            const int row = u.pm * BM + ai * HALF + wr * 64 + 16 * fq + fr;
            f32x2 pv; pv.x = v1; pv.y = v2;
            *(GAS f32x2*)(part + ((size_t)(u.pn * 4 + wc) * M + row) * 2) = pv;
        }
    }
};
constexpr size_t WRF_LAYER_BYTES = (size_t)64 * 3 * 2 * 64 * 16;
constexpr size_t WS_WRF = WS_TAB + 2 * MiB;
constexpr size_t WS_LIST = WS_MISC, WS_ROUTEW = WS_MISC + 2 * MiB, WS_PART = WS_MISC + 3 * MiB;
constexpr int LN_LG_STRIDE = 49;

__device__ __forceinline__ void build_router_frags(const Ins& I, Frame& F) {
    for (int idx = (F.vcu * NWAVES + F.wave) * 64 + F.lane; idx < 2 * 64 * 3 * 64; idx += F.G * NWAVES * 64) {
        const int lane = idx & 63, nt = (idx >> 6) % 3, s = (idx / 192) & 63, layer = idx / (192 * 64);
        const int g = lane >> 4, i = lane & 15, c = 16 * nt + i;
        float w[8];
#pragma unroll
        for (int j = 0; j < 8; ++j) { const int k = 32 * s + 8 * g + j;
            w[j] = c < 4 ? I.wgr[(size_t)layer * D * 4 + k * 4 + c] : (c < 36 ? I.wer[(size_t)layer * D * 32 + k * 32 + (c - 4)] : 0.f); }
        v4u hi, lo;
        hi.x = pk2(w[0], w[1]); hi.y = pk2(w[2], w[3]); hi.z = pk2(w[4], w[5]); hi.w = pk2(w[6], w[7]);
        lo.x = pk2(w[0] - pg8::bf_lo(hi.x), w[1] - pg8::bf_hi(hi.x)); lo.y = pk2(w[2] - pg8::bf_lo(hi.y), w[3] - pg8::bf_hi(hi.y));
        lo.z = pk2(w[4] - pg8::bf_lo(hi.z), w[5] - pg8::bf_hi(hi.z)); lo.w = pk2(w[6] - pg8::bf_lo(hi.w), w[7] - pg8::bf_hi(hi.w));
        GAS v4u* dst = (GAS v4u*)(F.ws + WS_WRF + (size_t)layer * WRF_LAYER_BYTES) + ((size_t)(s * 3 + nt) * 2) * 64 + lane;
        dst[0] = hi; dst[64] = lo;
    }
}

constexpr int LN_PL_OFF = 16384, LN_PL_WAVE = 32 * 48 * 4, LN_FL_OFF = LN_PL_OFF + 8 * LN_PL_WAVE;
__device__ __forceinline__ void ln_router_phase(Frame& F, const bf16* Y, const float* part, const float* gain, const float* bias, bf16* X1, unsigned char* XF8,
                                                const unsigned char* wrf, const float* bgr, const float* ber, unsigned* cnt, int* list, float* routew, bool do_route) {
    typedef short bf16x8 __attribute__((ext_vector_type(8))); typedef float f32x2 __attribute__((ext_vector_type(2)));
    LAS float* gl = (LAS float*)(F.lds); LAS float* bl = gl + D;
    for (int c = F.tid; c < D; c += NWAVES * 64) { gl[c] = gain[c]; bl[c] = bias[c]; }
    __syncthreads();
    LAS float* pl = (LAS float*)(F.lds + LN_PL_OFF + F.wave * LN_PL_WAVE);
    LAS float* fl = (LAS float*)(F.lds + LN_FL_OFF);
    const int lane = F.lane, g = lane >> 4, i = lane & 15;
    for (int task = F.vcu; task < M / 32; task += F.G) {
        const int row0 = task * 32;
        float mean[2], rstd[2];
#pragma unroll
        for (int rb = 0; rb < 2; ++rb) { const int row = row0 + 16 * rb + i; float s1 = 0.f, s2 = 0.f;
#pragma unroll
            for (int q = 0; q < 8; ++q) { const f32x2 pv = *(const GAS f32x2*)(part + ((size_t)(8 * g + q) * M + row) * 2); s1 += pv.x; s2 += pv.y; }
            s1 += __shfl_xor(s1, 16); s1 += __shfl_xor(s1, 32); s2 += __shfl_xor(s2, 16); s2 += __shfl_xor(s2, 32);
            const float mu = s1 * (1.f / D); const float var = s2 * (1.f / D) - mu * mu; mean[rb] = mu; rstd[rb] = rsqrtf(fmaxf(var, 0.f) + LN_EPS); }
        f32x4 acc[2][3];
#pragma unroll
        for (int rb = 0; rb < 2; ++rb)
#pragma unroll
            for (int nt = 0; nt < 3; ++nt) acc[rb][nt] = (f32x4){0.f, 0.f, 0.f, 0.f};
        const GAS v4u* wf = (const GAS v4u*)wrf + lane;
#pragma unroll 2
        for (int ss = 0; ss < 8; ++ss) {
            const int s = F.wave * 8 + ss, k0 = 32 * s + 8 * g;
            const f32x4 g0 = *(const LAS f32x4*)(gl + k0), g1 = *(const LAS f32x4*)(gl + k0 + 4), b0 = *(const LAS f32x4*)(bl + k0), b1 = *(const LAS f32x4*)(bl + k0 + 4);
            v4u bh[3], blo[3];
#pragma unroll
            for (int nt = 0; nt < 3; ++nt) { bh[nt] = wf[(size_t)((s * 3 + nt) * 2) * 64]; blo[nt] = wf[(size_t)((s * 3 + nt) * 2 + 1) * 64]; }
#pragma unroll
            for (int rb = 0; rb < 2; ++rb) {
                const size_t off = (size_t)(row0 + 16 * rb + i) * D + k0;
                const v4u yw = *(const GAS v4u*)(Y + off);
                const float mu = mean[rb], rs = rstd[rb];
                float x[8];
                x[0] = (pg8::bf_lo(yw.x) - mu) * rs * g0.x + b0.x; x[1] = (pg8::bf_hi(yw.x) - mu) * rs * g0.y + b0.y; x[2] = (pg8::bf_lo(yw.y) - mu) * rs * g0.z + b0.z; x[3] = (pg8::bf_hi(yw.y) - mu) * rs * g0.w + b0.w;
                x[4] = (pg8::bf_lo(yw.z) - mu) * rs * g1.x + b1.x; x[5] = (pg8::bf_hi(yw.z) - mu) * rs * g1.y + b1.y; x[6] = (pg8::bf_lo(yw.w) - mu) * rs * g1.z + b1.z; x[7] = (pg8::bf_hi(yw.w) - mu) * rs * g1.w + b1.w;
                v4u hi, lo;
                hi.x = pk2(x[0], x[1]); hi.y = pk2(x[2], x[3]); hi.z = pk2(x[4], x[5]); hi.w = pk2(x[6], x[7]);
                { pg8::u32x2 f8; f8.x = pk4_fp8(x[0], x[1], x[2], x[3]); f8.y = pk4_fp8(x[4], x[5], x[6], x[7]); *(GAS pg8::u32x2*)(XF8 + off) = f8; }
                lo.x = pk2(x[0] - pg8::bf_lo(hi.x), x[1] - pg8::bf_hi(hi.x)); lo.y = pk2(x[2] - pg8::bf_lo(hi.y), x[3] - pg8::bf_hi(hi.y));
                lo.z = pk2(x[4] - pg8::bf_lo(hi.z), x[5] - pg8::bf_hi(hi.z)); lo.w = pk2(x[6] - pg8::bf_lo(hi.w), x[7] - pg8::bf_hi(hi.w));
                const bf16x8 ah = __builtin_bit_cast(bf16x8, hi), al = __builtin_bit_cast(bf16x8, lo);
#pragma unroll
                for (int nt = 0; nt < 3; ++nt) {
                    acc[rb][nt] = __builtin_amdgcn_mfma_f32_16x16x32_bf16(ah, __builtin_bit_cast(bf16x8, bh[nt]), acc[rb][nt], 0, 0, 0);
                    acc[rb][nt] = __builtin_amdgcn_mfma_f32_16x16x32_bf16(al, __builtin_bit_cast(bf16x8, bh[nt]), acc[rb][nt], 0, 0, 0);
                    acc[rb][nt] = __builtin_amdgcn_mfma_f32_16x16x32_bf16(ah, __builtin_bit_cast(bf16x8, blo[nt]), acc[rb][nt], 0, 0, 0);
                }
            }
        }
#pragma unroll
        for (int rb = 0; rb < 2; ++rb)
#pragma unroll
            for (int nt = 0; nt < 3; ++nt)
#pragma unroll
                for (int j = 0; j < 4; ++j) pl[(16 * rb + 4 * g + j) * 48 + 16 * nt + i] = acc[rb][nt][j];
        __syncthreads();
        { const int row = F.tid >> 4, c = F.tid & 15;
#pragma unroll
          for (int nt = 0; nt < 3; ++nt) { float sum = 0.f;
#pragma unroll
              for (int w = 0; w < 8; ++w) sum += *(const LAS float*)(F.lds + LN_PL_OFF + w * LN_PL_WAVE + (row * 48 + 16 * nt + c) * 4);
              fl[row * LN_LG_STRIDE + 16 * nt + c] = sum; } }
        __syncthreads();
        if (F.tid < 32 && do_route) {
            const LAS float* lr = fl + F.tid * LN_LG_STRIDE; const int row = row0 + F.tid;
            float gv[4];
#pragma unroll
            for (int q = 0; q < 4; ++q) gv[q] = lr[q] + bgr[q];
            int gs = 0; float gm = gv[0];
#pragma unroll
            for (int q = 1; q < 4; ++q) if (gv[q] > gm) { gm = gv[q]; gs = q; }
            float den = 0.f;
#pragma unroll
            for (int q = 0; q < 4; ++q) den += __expf(gv[q] - gm);
            const float wg = 1.f / den;
            float ev[8];
#pragma unroll
            for (int q = 0; q < 8; ++q) ev[q] = lr[4 + gs * 8 + q] + ber[gs * 8 + q];
            int e1 = 0; float v1 = ev[0];
#pragma unroll
            for (int q = 1; q < 8; ++q) if (ev[q] > v1) { v1 = ev[q]; e1 = q; }
            int e2 = -1; float v2 = -3.0e38f;
#pragma unroll
            for (int q = 0; q < 8; ++q) if (q != e1 && ev[q] > v2) { v2 = ev[q]; e2 = q; }
            const float a1 = 1.f / (1.f + __expf(v2 - v1));
            const int E0 = gs * 8 + e1, E1 = gs * 8 + e2;
            const unsigned p0 = __hip_atomic_fetch_add(cnt + 64 * E0, 1u, __ATOMIC_RELAXED, __HIP_MEMORY_SCOPE_AGENT);
            const unsigned p1 = __hip_atomic_fetch_add(cnt + 64 * E1, 1u, __ATOMIC_RELAXED, __HIP_MEMORY_SCOPE_AGENT);
            list[(size_t)E0 * M + p0] = row * 2; list[(size_t)E1 * M + p1] = row * 2 + 1;
            routew[row * 2] = a1 * wg; routew[row * 2 + 1] = (1.f - a1) * wg;
        }
        __syncthreads();
    }
}

template <bool GATHER_> struct MoeOrder {
    static constexpr bool GATHER = GATHER_, CARRY = false; static constexpr int MODE = 1;
    const LAS int* tab; const unsigned* cnt; const int* list; const char* A; const char* B; size_t tA, bE, tB; int nN, G, c;
    int lo, hi;
    int n_busy, head;
    __device__ __forceinline__ bool next(int i, pg8::Unit& u) const {
        const int n_idle = G - n_busy; int L;
        if (c >= n_busy) { const int j = c - n_busy; L = (i < head) ? i * n_idle + j : head * n_idle + (i - head) * G + j; }
        else L = head * n_idle + i * G + n_idle + c;
        L += lo; if (L >= hi) return false;
        const int sh = nN == 8 ? 3 : 2, t = L >> sh, E = tab[64 + t];
        u.pm = t; u.pn = L & (nN - 1); u.z = E; u.aux = t - tab[E]; return true;
    }
    __device__ __forceinline__ const char* abase(const pg8::Unit& u) const { return GATHER ? A : A + (size_t)u.pm * tA; }
    __device__ __forceinline__ const char* bbase(const pg8::Unit& u) const { return B + (size_t)u.z * bE + (size_t)u.pn * tB; }
    __device__ __forceinline__ unsigned arow(const pg8::Unit& u, int r) const {
        if (!GATHER) return (unsigned)r;
        const unsigned pos = (unsigned)(u.aux * 256 + r); const unsigned n = cnt[64 * u.z];
        return pos < n ? (unsigned)(list[(size_t)u.z * M + pos] >> 1) : 0u;
    }
    __device__ __forceinline__ void a_ready(const pg8::Unit&) const {}
    __device__ __forceinline__ void done(const pg8::Unit&) const {}
};
__device__ __forceinline__ void moe_build_table(Frame& F, LAS int* tab, const unsigned* cnt) {
    if (F.tid == 0) { int acc = 0; for (int e = 0; e < 32; ++e) { tab[e] = acc; acc += (int)((cnt[64 * e] + 255u) >> 8); } tab[32] = acc; }
    __syncthreads();
    if (F.tid < tab[32] && F.tid < 448) { int E = 0; for (int e = 1; e < 32; ++e) E = (tab[e] <= F.tid) ? e : E; tab[64 + F.tid] = E; }
    __syncthreads();
}
struct EpiSwiGLU {
    static constexpr bool PERM = true;
    unsigned char* H; float inv;
    __device__ __forceinline__ void operator()(const pg8::f32x4 (&acc)[2][2][4][2], const pg8::Unit& u, int wr, int wc, int fr, int fq) const {
        using namespace pg8;
        const int row0 = u.pm * BM + wr * 64 + fr, col0 = u.pn * 128 + wc * 32 + 8 * fq;
#pragma unroll
        for (int ai = 0; ai < 2; ++ai)
#pragma unroll
            for (int m = 0; m < 4; ++m) { const f32x4 g0 = acc[ai][0][m][0] * inv, g1 = acc[ai][0][m][1] * inv, u0 = acc[ai][1][m][0] * inv, u1 = acc[ai][1][m][1] * inv;
                u32x2 w; w.x = pk4_fp8(silu_f(g0[0]) * u0[0], silu_f(g0[1]) * u0[1], silu_f(g0[2]) * u0[2], silu_f(g0[3]) * u0[3]);
                w.y = pk4_fp8(silu_f(g1[0]) * u1[0], silu_f(g1[1]) * u1[1], silu_f(g1[2]) * u1[2], silu_f(g1[3]) * u1[3]);
                *(GAS u32x2*)(H + (size_t)(row0 + ai * HALF + m * 16) * FF + col0) = w; }
    }
};
constexpr float O_SCALE = 16.0f;
__device__ __forceinline__ void fp8x4_f32(unsigned w, float* o) { const pg8::f32x2 lo = __builtin_amdgcn_cvt_pk_f32_fp8((int)w, false), hi = __builtin_amdgcn_cvt_pk_f32_fp8((int)w, true); o[0] = lo.x; o[1] = lo.y; o[2] = hi.x; o[3] = hi.y; }
struct EpiScatter {
    static constexpr bool PERM = true;
    const unsigned* cnt; const int* list; unsigned char* O01; float inv;
    __device__ __forceinline__ void operator()(const pg8::f32x4 (&acc)[2][2][4][2], const pg8::Unit& u, int wr, int wc, int fr, int fq) const {
        using namespace pg8;
        const unsigned n = cnt[64 * u.z]; const int col0 = u.pn * BM + wc * 32 + 8 * fq;
        int tks[2][4];
#pragma unroll
        for (int ai = 0; ai < 2; ++ai)
#pragma unroll
            for (int m = 0; m < 4; ++m) { const unsigned pos = (unsigned)(u.aux * 256 + ai * HALF + wr * 64 + m * 16 + fr); tks[ai][m] = pos < n ? list[(size_t)u.z * M + pos] : -1; }
        __builtin_amdgcn_sched_barrier(0);
#pragma unroll
        for (int ai = 0; ai < 2; ++ai)
#pragma unroll
            for (int m = 0; m < 4; ++m) { const int tk = tks[ai][m];
                if (tk >= 0) { unsigned char* dst = O01 + ((size_t)(tk & 1) * M + (size_t)(tk >> 1)) * D + col0;
#pragma unroll
                    for (int bj = 0; bj < 2; ++bj) { const f32x4 v0 = acc[ai][bj][m][0] * inv, v1 = acc[ai][bj][m][1] * inv;
                        u32x2 w; w.x = pk4_fp8(v0[0], v0[1], v0[2], v0[3]); w.y = pk4_fp8(v1[0], v1[1], v1[2], v1[3]);
                        *(GAS u32x2*)(dst + bj * HALF) = w; } } }
    }
};

template <bool FINAL> __device__ __forceinline__ void combine_ln_phase(Frame& F, const bf16* Y, const float* part, const float* gA, const float* bA, const unsigned char* O01, const float* routew, const float* gain, const float* bias, bf16* outb, float* outf, unsigned char* out8 = nullptr, float* sx = nullptr) {
    const int gw = F.vcu * NWAVES + F.wave, NGW = F.G * NWAVES;
    for (int row = gw; row < M; row += NGW) {
        const float w0 = routew[row * 2] * (1.f / O_SCALE), w1 = routew[row * 2 + 1] * (1.f / O_SCALE);
        float mu1, rs1;
        { pg8::f32x2 pv; pv.x = 0.f; pv.y = 0.f; if (F.lane < 32) pv = *(const GAS pg8::f32x2*)(part + ((size_t)F.lane * M + row) * 2);
          const float t1 = wave_sum(pv.x), t2 = wave_sum(pv.y); mu1 = t1 * (1.f / D); const float var = t2 * (1.f / D) - mu1 * mu1; rs1 = rsqrtf(fmaxf(var, 0.f) + LN_EPS); }
        float v[4][8]; float s = 0.f;
#pragma unroll
        for (int j = 0; j < 4; ++j) { const size_t off = (size_t)row * D + 8 * (F.lane + 64 * j);
            const v4u yw = __builtin_nontemporal_load((const GAS v4u*)(Y + off));
            const pg8::u32x2 aw = __builtin_nontemporal_load((const GAS pg8::u32x2*)(O01 + off)), bw = __builtin_nontemporal_load((const GAS pg8::u32x2*)(O01 + (size_t)M * D + off));
            const int colA = 8 * (F.lane + 64 * j);
            const f32x4 ga0 = *(const GAS f32x4*)(gA + colA), ga1 = *(const GAS f32x4*)(gA + colA + 4), ba0 = *(const GAS f32x4*)(bA + colA), ba1 = *(const GAS f32x4*)(bA + colA + 4);
            float a[8], b[8]; fp8x4_f32(aw.x, a); fp8x4_f32(aw.y, a + 4); fp8x4_f32(bw.x, b); fp8x4_f32(bw.y, b + 4);
            float x[8];
            x[0] = (pg8::bf_lo(yw.x) - mu1) * rs1 * ga0.x + ba0.x; x[1] = (pg8::bf_hi(yw.x) - mu1) * rs1 * ga0.y + ba0.y; x[2] = (pg8::bf_lo(yw.y) - mu1) * rs1 * ga0.z + ba0.z; x[3] = (pg8::bf_hi(yw.y) - mu1) * rs1 * ga0.w + ba0.w;
            x[4] = (pg8::bf_lo(yw.z) - mu1) * rs1 * ga1.x + ba1.x; x[5] = (pg8::bf_hi(yw.z) - mu1) * rs1 * ga1.y + ba1.y; x[6] = (pg8::bf_lo(yw.w) - mu1) * rs1 * ga1.z + ba1.z; x[7] = (pg8::bf_hi(yw.w) - mu1) * rs1 * ga1.w + ba1.w;
#pragma unroll
            for (int e = 0; e < 8; ++e) v[j][e] = ALPHA * x[e] + w0 * a[e] + w1 * b[e];
#pragma unroll
            for (int e = 0; e < 8; ++e) s += v[j][e]; }
        const float mean = wave_sum(s) * (1.f / D); float q = 0.f;
#pragma unroll
        for (int j = 0; j < 4; ++j)
#pragma unroll
            for (int e = 0; e < 8; ++e) { v[j][e] -= mean; q += v[j][e] * v[j][e]; }
        const float rstd = rsqrtf(wave_sum(q) * (1.f / D) + LN_EPS);
#pragma unroll
        for (int j = 0; j < 4; ++j) { const int col = 8 * (F.lane + 64 * j); const size_t off = (size_t)row * D + col;
            const f32x4 g0 = *(const GAS f32x4*)(gain + col), g1 = *(const GAS f32x4*)(gain + col + 4), b0 = *(const GAS f32x4*)(bias + col), b1 = *(const GAS f32x4*)(bias + col + 4);
            f32x4 o0, o1;
            o0.x = v[j][0] * rstd * g0.x + b0.x; o0.y = v[j][1] * rstd * g0.y + b0.y; o0.z = v[j][2] * rstd * g0.z + b0.z; o0.w = v[j][3] * rstd * g0.w + b0.w;
            o1.x = v[j][4] * rstd * g1.x + b1.x; o1.y = v[j][5] * rstd * g1.y + b1.y; o1.z = v[j][6] * rstd * g1.z + b1.z; o1.w = v[j][7] * rstd * g1.w + b1.w;
            if (FINAL) { __builtin_nontemporal_store(o0, (GAS f32x4*)(outf + off)); __builtin_nontemporal_store(o1, (GAS f32x4*)(outf + off + 4)); }
            else { v4u w; w.x = pk2(o0.x, o0.y); w.y = pk2(o0.z, o0.w); w.z = pk2(o1.x, o1.y); w.w = pk2(o1.z, o1.w); *(GAS v4u*)(outb + off) = w;
                v[j][0] = o0.x; v[j][1] = o0.y; v[j][2] = o0.z; v[j][3] = o0.w; v[j][4] = o1.x; v[j][5] = o1.y; v[j][6] = o1.z; v[j][7] = o1.w; } }
        if (!FINAL) {
            float mx = 0.f;
#pragma unroll
            for (int j = 0; j < 4; ++j)
#pragma unroll
                for (int e = 0; e < 8; ++e) mx = __builtin_fmaxf(mx, __builtin_fabsf(v[j][e]));
#pragma unroll
            for (int o = 1; o < 64; o <<= 1) mx = __builtin_fmaxf(mx, __shfl_xor(mx, o));
            const float sc = mx > 0.f ? mx * (1.f / 127.f) : 1.f, inv = 1.f / sc;
            if (F.lane == 0) sx[row] = sc;
#pragma unroll
            for (int j = 0; j < 4; ++j) { pg8::u32x2 w8; w8.x = pk4_i8(v[j][0] * inv, v[j][1] * inv, v[j][2] * inv, v[j][3] * inv); w8.y = pk4_i8(v[j][4] * inv, v[j][5] * inv, v[j][6] * inv, v[j][7] * inv);
                *(GAS pg8::u32x2*)(out8 + (size_t)row * D + 8 * (F.lane + 64 * j)) = w8; }
        }
    }
}
constexpr size_t WS_DECAY = WS_TAB + 3 * MiB;
__device__ __forceinline__ void build_decay_table(const Ins& I, Frame& F) {
    if (blockIdx.x == 0 && F.tid < 16) { const int h = F.tid >> 1, d = F.tid & 1; const float v = (d ? I.dbw : I.dfw)[h];
        ((float*)(F.ws + WS_DECAY))[F.tid] = log1pf(-expf(v)) * 1.4426950408889634f; }
}
struct EpiRetProj {
    static constexpr bool PERM = true;
    unsigned short *Q2, *K2, *G; const float *tcos, *tsin;
    __device__ __forceinline__ void operator()(const pg8::f32x4 (&acc)[2][2][4][2], const pg8::Unit& u, int wr, int wc, int fr, int fq) const {
        using namespace pg8;
        const int row0 = u.pm * BM + wr * 64 + fr, i0 = wc * 32 + 8 * fq;
        if (u.pn >= 16) {
            const int col0 = (u.pn - 16) * BM + i0;
#pragma unroll
            for (int ai = 0; ai < 2; ++ai)
#pragma unroll
                for (int m = 0; m < 4; ++m) { unsigned short* rowp = G + (size_t)(row0 + ai * HALF + m * 16) * RVW + col0;
#pragma unroll
                    for (int bj = 0; bj < 2; ++bj) { const f32x4 v0 = acc[ai][bj][m][0], v1 = acc[ai][bj][m][1];
                        u32x4 w; w.x = cvt_pk_bf16(silu_f(v0[0]), silu_f(v0[1])); w.y = cvt_pk_bf16(silu_f(v0[2]), silu_f(v0[3])); w.z = cvt_pk_bf16(silu_f(v1[0]), silu_f(v1[1])); w.w = cvt_pk_bf16(silu_f(v1[2]), silu_f(v1[3]));
                        __builtin_nontemporal_store(w, (GAS u32x4*)(rowp + bj * HALF));
#ifdef EXP_DOUBLE_STORE
                        *(GAS u32x4*)(rowp + bj * HALF + (size_t)(WS_A6 - WS_A5) / 2) = w;
#endif
                        } }
        } else {
            const int h = u.pn & 7; const bool isk = u.pn >= 8; unsigned short* base = isk ? K2 : Q2; const float sc = isk ? 0.0625f : 1.0f;
#pragma unroll
            for (int ai = 0; ai < 2; ++ai)
#pragma unroll
                for (int m = 0; m < 4; ++m) { const int tok = row0 + ai * HALF + m * 16, b = tok >> 11, s = tok & 2047;
                    const f32x4 c0 = *(const GAS f32x4*)(tcos + s * 128 + i0), c1 = *(const GAS f32x4*)(tcos + s * 128 + i0 + 4), s0 = *(const GAS f32x4*)(tsin + s * 128 + i0), s1 = *(const GAS f32x4*)(tsin + s * 128 + i0 + 4);
                    const f32x4 a0 = acc[ai][0][m][0], a1 = acc[ai][0][m][1], b0 = acc[ai][1][m][0], b1 = acc[ai][1][m][1];
                    const f32x4 o10 = (a0 * c0 - b0 * s0) * sc, o11 = (a1 * c1 - b1 * s1) * sc, o20 = (a0 * s0 + b0 * c0) * sc, o21 = (a1 * s1 + b1 * c1) * sc;
                    unsigned short* dst = base + ((size_t)(b * RH + h) * SEQ + s) * RQK + i0;
                    u32x4 w1, w2; w1.x = cvt_pk_bf16(o10[0], o10[1]); w1.y = cvt_pk_bf16(o10[2], o10[3]); w1.z = cvt_pk_bf16(o11[0], o11[1]); w1.w = cvt_pk_bf16(o11[2], o11[3]);
                    w2.x = cvt_pk_bf16(o20[0], o20[1]); w2.y = cvt_pk_bf16(o20[2], o20[3]); w2.z = cvt_pk_bf16(o21[0], o21[1]); w2.w = cvt_pk_bf16(o21[2], o21[3]);
                    *(GAS u32x4*)dst = w1; *(GAS u32x4*)(dst + 128) = w2; }
        }
    }
};
struct EpiDecay {
    static constexpr bool PERM = true;
    unsigned short* P; const float* lg2;
    __device__ __forceinline__ void operator()(const pg8::f32x4 (&acc)[2][2][4][2], const pg8::Unit& u, int wr, int wc, int fr, int fq) const {
        using namespace pg8;
        const int h = u.z & 7; const float lf = lg2[2 * h], lb = lg2[2 * h + 1];
        int r0 = wr * 64 + fr, c0 = wc * 32 + 8 * fq;
        asm volatile("" : "+v"(r0), "+v"(c0));
        unsigned short* base = P + (size_t)u.z * SEQ * SEQ + (size_t)(u.pm * BM) * SEQ + u.pn * BM;
        if (u.pm != u.pn) {
            const bool lower = u.pm > u.pn; const float lg = lower ? lf : lb;
            const int dp = 256 * (lower ? u.pm - u.pn : u.pn - u.pm);
#pragma unroll
            for (int bj = 0; bj < 2; ++bj) {
                float colf[8];
#pragma unroll
                for (int k = 0; k < 8; ++k) { const int c = c0 + bj * HALF + k; colf[k] = __builtin_amdgcn_exp2f(lg * (float)(lower ? dp - c : c)); }
#pragma unroll
                for (int ai = 0; ai < 2; ++ai)
#pragma unroll
                    for (int m = 0; m < 4; ++m) { const int r = r0 + ai * HALF + m * 16; const float rf = __builtin_amdgcn_exp2f(lg * (float)(lower ? r : dp - r));
                        const f32x4 v0 = acc[ai][bj][m][0], v1 = acc[ai][bj][m][1];
                        u32x4 w; w.x = cvt_pk_bf16(v0[0] * rf * colf[0], v0[1] * rf * colf[1]); w.y = cvt_pk_bf16(v0[2] * rf * colf[2], v0[3] * rf * colf[3]);
                        w.z = cvt_pk_bf16(v1[0] * rf * colf[4], v1[1] * rf * colf[5]); w.w = cvt_pk_bf16(v1[2] * rf * colf[6], v1[3] * rf * colf[7]);
                        *(GAS u32x4*)(base + (size_t)r * SEQ + c0 + bj * HALF) = w; __builtin_amdgcn_sched_barrier(0); }
                asm volatile("" ::: "memory");
            }
        } else {
#pragma unroll
            for (int ai = 0; ai < 2; ++ai)
#pragma unroll
                for (int m = 0; m < 4; ++m) { const int r = r0 + ai * HALF + m * 16; unsigned short* rowp = base + (size_t)r * SEQ + c0;
#pragma unroll
                    for (int bj = 0; bj < 2; ++bj) { float f[8];
#pragma unroll
                        for (int k = 0; k < 8; ++k) { const int d = r - (c0 + bj * HALF + k); f[k] = __builtin_amdgcn_exp2f(d >= 0 ? lf * (float)d : lb * (float)(-d)); }
                        const f32x4 v0 = acc[ai][bj][m][0], v1 = acc[ai][bj][m][1];
                        u32x4 w; w.x = cvt_pk_bf16(v0[0] * f[0], v0[1] * f[1]); w.y = cvt_pk_bf16(v0[2] * f[2], v0[3] * f[3]); w.z = cvt_pk_bf16(v1[0] * f[4], v1[1] * f[5]); w.w = cvt_pk_bf16(v1[2] * f[6], v1[3] * f[7]);
                        *(GAS u32x4*)(rowp + bj * HALF) = w; __builtin_amdgcn_sched_barrier(0); } }
        }
    }
};
struct EpiRetOut {
    static constexpr bool PERM = true;
    unsigned short* Y; int b0;
    __device__ __forceinline__ void operator()(const pg8::f32x4 (&acc)[2][2][4][2], const pg8::Unit& u, int wr, int wc, int fr, int fq) const {
        using namespace pg8;
        const int b = b0 + (u.z >> 3), h = u.z & 7;
        unsigned short* base = Y + ((size_t)b * SEQ + u.pm * BM + wr * 64 + fr) * RVW + h * RV + u.pn * BM + wc * 32 + 8 * fq;
#pragma unroll
        for (int ai = 0; ai < 2; ++ai)
#pragma unroll
            for (int m = 0; m < 4; ++m) { unsigned short* rowp = base + (size_t)(ai * HALF + m * 16) * RVW;
#pragma unroll
                for (int bj = 0; bj < 2; ++bj) { const f32x4 v0 = acc[ai][bj][m][0], v1 = acc[ai][bj][m][1];
                    u32x4 w; w.x = cvt_pk_bf16(v0[0], v0[1]); w.y = cvt_pk_bf16(v0[2], v0[3]); w.z = cvt_pk_bf16(v1[0], v1[1]); w.w = cvt_pk_bf16(v1[2], v1[3]);
                    *(GAS u32x4*)(rowp + bj * HALF) = w; } }
    }
};
__device__ __forceinline__ void gn_gate_phase(Frame& F, const bf16* Y, bf16* G) {
    const int gw = F.vcu * NWAVES + F.wave, NGW = F.G * NWAVES;
    for (int item = gw; item < M * RH; item += NGW) {
        const size_t off = (size_t)item * RV + 8 * F.lane;
        const v4u yw = __builtin_nontemporal_load((const GAS v4u*)(Y + off)), gv = __builtin_nontemporal_load((const GAS v4u*)(G + off));
        float y[8] = {pg8::bf_lo(yw.x), pg8::bf_hi(yw.x), pg8::bf_lo(yw.y), pg8::bf_hi(yw.y), pg8::bf_lo(yw.z), pg8::bf_hi(yw.z), pg8::bf_lo(yw.w), pg8::bf_hi(yw.w)};
        float g[8] = {pg8::bf_lo(gv.x), pg8::bf_hi(gv.x), pg8::bf_lo(gv.y), pg8::bf_hi(gv.y), pg8::bf_lo(gv.z), pg8::bf_hi(gv.z), pg8::bf_lo(gv.w), pg8::bf_hi(gv.w)};
        float q = 0.f;
#pragma unroll
        for (int e = 0; e < 8; ++e) q += y[e] * y[e];
        const float r = rsqrtf(wave_sum(q) * (1.f / RV) + GN_EPS);
        v4u o; o.x = pk2(g[0] * y[0] * r, g[1] * y[1] * r); o.y = pk2(g[2] * y[2] * r, g[3] * y[3] * r); o.z = pk2(g[4] * y[4] * r, g[5] * y[5] * r); o.w = pk2(g[6] * y[6] * r, g[7] * y[7] * r);
        *(GAS v4u*)(G + off) = o;
    }
}
constexpr size_t WS_ST = WS_A1;
constexpr size_t WS_VTC = WS_A5;
constexpr size_t WS_KT = WS_A6;
constexpr size_t WS_PD = WS_WM1;
constexpr size_t WS_Q2 = 880 * MiB, WS_K2 = 944 * MiB;

struct EpiRetProj2 {
    static constexpr bool PERM = true;
    unsigned short *Q2, *K2; const float *tcos, *tsin, *rotd; const float* sx; float sw;
    __device__ __forceinline__ void operator()(const pg8::f32x4 (&acc)[2][2][4][2], const pg8::Unit& u, int wr, int wc, int fr, int fq) const {
        using namespace pg8;
        const int i0 = wc * 32 + 8 * fq, h = u.pn & 7, b = u.pm >> 3, cc = u.pm & 7, z = b * RH + h; const bool isk = u.pn >= 8;
        unsigned short* base = isk ? K2 : Q2; const float sc = (isk ? 0.0625f : 1.0f) * sw;
        const int iw0 = wr * 64 + fr;
        const int sb0 = cc * 256 + iw0;
        float rsx[2][4];
#pragma unroll
        for (int ai = 0; ai < 2; ++ai)
#pragma unroll
            for (int m = 0; m < 4; ++m) rsx[ai][m] = sx[b * SEQ + sb0 + ai * HALF + m * 16];
        f32x4 c[2], s[2], c16[2], s16[2];
#pragma unroll
        for (int j = 0; j < 2; ++j) { c[j] = *(const GAS f32x4*)(tcos + sb0 * 128 + i0 + 4 * j); s[j] = *(const GAS f32x4*)(tsin + sb0 * 128 + i0 + 4 * j);
            c16[j] = *(const GAS f32x4*)(rotd + i0 + 4 * j); s16[j] = *(const GAS f32x4*)(rotd + 128 + i0 + 4 * j); }
#pragma unroll
        for (int ai = 0; ai < 2; ++ai) {
#pragma unroll
            for (int m = 0; m < 4; ++m) { const int st = sb0 + ai * HALF + m * 16; const float rs = rsx[ai][m];
                const f32x4 a0 = i2f4(acc[ai][0][m][0]) * rs, a1 = i2f4(acc[ai][0][m][1]) * rs, b0 = i2f4(acc[ai][1][m][0]) * rs, b1 = i2f4(acc[ai][1][m][1]) * rs;
                const f32x4 o10 = (a0 * c[0] - b0 * s[0]) * sc, o11 = (a1 * c[1] - b1 * s[1]) * sc, o20 = (a0 * s[0] + b0 * c[0]) * sc, o21 = (a1 * s[1] + b1 * c[1]) * sc;
                unsigned short* dst = base + ((size_t)z * SEQ + st) * RQK + i0;
                u32x4 w1, w2; w1.x = cvt_pk_bf16(o10[0], o10[1]); w1.y = cvt_pk_bf16(o10[2], o10[3]); w1.z = cvt_pk_bf16(o11[0], o11[1]); w1.w = cvt_pk_bf16(o11[2], o11[3]);
                w2.x = cvt_pk_bf16(o20[0], o20[1]); w2.y = cvt_pk_bf16(o20[2], o20[3]); w2.z = cvt_pk_bf16(o21[0], o21[1]); w2.w = cvt_pk_bf16(o21[2], o21[3]);
                *(GAS u32x4*)dst = w1; *(GAS u32x4*)(dst + 128) = w2;
                const int nrot = (ai == 1 && m == 3) ? 0 : (m == 3 ? 5 : 1);
#pragma unroll
                for (int q = 0; q < nrot; ++q)
#pragma unroll
                    for (int j = 0; j < 2; ++j) { const f32x4 cn = c[j] * c16[j] - s[j] * s16[j], sn = s[j] * c16[j] + c[j] * s16[j]; c[j] = cn; s[j] = sn; } }
        }
    }
};
struct EpiVtCat {
    static constexpr bool PERM = true;
    unsigned short* VTC; const float* sx; float sw;
    __device__ __forceinline__ void operator()(const pg8::f32x4 (&acc)[2][2][4][2], const pg8::Unit& u, int wr, int wc, int fr, int fq) const {
        using namespace pg8;
        const int h = u.pm >> 1, dv0 = (u.pm & 1) * 256, b = u.pn >> 3, cc = u.pn & 7;
        unsigned short* base = VTC + ((size_t)((b * RH + h) * 8 + cc) * RV + dv0 + wr * 64 + fr) * 256 + wc * 32 + 8 * fq;
        f32x4 cs[2][2];
#pragma unroll
        for (int bj = 0; bj < 2; ++bj) { const float* sp = sx + u.pn * 256 + bj * HALF + wc * 32 + 8 * fq; cs[bj][0] = *(const GAS f32x4*)sp * sw; cs[bj][1] = *(const GAS f32x4*)(sp + 4) * sw; }
#pragma unroll
        for (int ai = 0; ai < 2; ++ai)
#pragma unroll
            for (int m = 0; m < 4; ++m) { unsigned short* rowp = base + (size_t)(ai * HALF + m * 16) * 256;
#pragma unroll
                for (int bj = 0; bj < 2; ++bj) { const f32x4 v0 = i2f4(acc[ai][bj][m][0]) * cs[bj][0], v1 = i2f4(acc[ai][bj][m][1]) * cs[bj][1];
                    u32x4 w; w.x = cvt_pk_bf16(v0[0], v0[1]); w.y = cvt_pk_bf16(v0[2], v0[3]); w.z = cvt_pk_bf16(v1[0], v1[1]); w.w = cvt_pk_bf16(v1[2], v1[3]);
                    *(GAS u32x4*)(rowp + bj * HALF) = w; } }
    }
};
struct PairOrder {
    static constexpr bool GATHER = false, CARRY = false; static constexpr int MODE = 2;
    const char* A; const char* B; int G, c;
    __device__ __forceinline__ bool next(int i, pg8::Unit& u) const { const int p = c + (i >> 1) * G; if (p >= 512) return false; u.pm = p >> 3; u.pn = (p & 7) + 8 * (i & 1); u.z = 0; u.aux = 0; return true; }
    __device__ __forceinline__ const char* abase(const pg8::Unit& u) const { return A + (size_t)u.pm * 256 * D * 2; }
    __device__ __forceinline__ const char* bbase(const pg8::Unit& u) const { return B + (size_t)u.pn * 256 * D * 2; }
    __device__ __forceinline__ unsigned arow(const pg8::Unit&, int r) const { return (unsigned)r; }
    __device__ __forceinline__ void a_ready(const pg8::Unit&) const {}
    __device__ __forceinline__ void done(const pg8::Unit&) const {}
};
struct DiagOrder {
    static constexpr bool GATHER = false, CARRY = false;
    const char* Q; const char* K; int p0, pstep, npairs;
    __device__ __forceinline__ bool next(int i, pg8::Unit& u) const { if (i >= npairs) return false; const int p = p0 + i * pstep; const int pm = p >> 3; u.z = (pm >> 3) * 8 + (p & 7); u.pm = pm & 7; u.pn = pm & 7; u.aux = 0; return true; }
    __device__ __forceinline__ const char* abase(const pg8::Unit& u) const { return Q + ((size_t)u.z * SEQ + u.pm * 256) * RQK * 2; }
    __device__ __forceinline__ const char* bbase(const pg8::Unit& u) const { return K + ((size_t)u.z * SEQ + u.pm * 256) * RQK * 2; }
    __device__ __forceinline__ unsigned arow(const pg8::Unit&, int r) const { return (unsigned)r; }
    __device__ __forceinline__ void a_ready(const pg8::Unit&) const {}
    __device__ __forceinline__ void done(const pg8::Unit&) const {}
};
struct EpiDiag {
    static constexpr bool PERM = true;
    unsigned short* PD; const float* lg2;
    __device__ __forceinline__ void operator()(const pg8::f32x4 (&acc)[2][2][4][2], const pg8::Unit& u, int wr, int wc, int fr, int fq) const {
        using namespace pg8;
        const int h = u.z & 7; const float lf = lg2[2 * h], lb = lg2[2 * h + 1];
        int r0 = wr * 64 + fr, c0 = wc * 32 + 8 * fq;
        asm volatile("" : "+v"(r0), "+v"(c0));
        unsigned short* base = PD + (size_t)(u.z * 8 + u.pm) * 256 * 256;
#pragma unroll
        for (int ai = 0; ai < 2; ++ai)
#pragma unroll
            for (int m = 0; m < 4; ++m) { const int r = r0 + ai * HALF + m * 16; unsigned short* rowp = base + (size_t)r * 256 + c0;
#pragma unroll
                for (int bj = 0; bj < 2; ++bj) { float f[8];
#pragma unroll
                    for (int k = 0; k < 8; ++k) { const int d = r - (c0 + bj * HALF + k); f[k] = __builtin_amdgcn_exp2f(d >= 0 ? lf * (float)d : lb * (float)(-d)); }
                    const f32x4 v0 = acc[ai][bj][m][0], v1 = acc[ai][bj][m][1];
                    u32x4 w; w.x = cvt_pk_bf16(v0[0] * f[0], v0[1] * f[1]); w.y = cvt_pk_bf16(v0[2] * f[2], v0[3] * f[3]); w.z = cvt_pk_bf16(v1[0] * f[4], v1[1] * f[5]); w.w = cvt_pk_bf16(v1[2] * f[6], v1[3] * f[7]);
                    *(GAS u32x4*)(rowp + bj * HALF) = w; __builtin_amdgcn_sched_barrier(0); } }
    }
};
__device__ __forceinline__ void kt_phase(Frame& F, const bf16* K2, bf16* KT, const float* lg2, int p0, int pstep, int npairs) {
    constexpr int LDT = 72;
    LAS bf16* T = (LAS bf16*)(F.lds + RING_OFF + F.wave * 16384);
    const int lane = F.lane, q = lane & 7, rr = lane >> 3;
    for (int it = F.wave; it < 16 * npairs; it += NWAVES) {
        const int p = p0 + (it >> 4) * pstep, blk = it & 15, pm = p >> 3, z = (pm >> 3) * 8 + (p & 7), h = z & 7, s0 = (pm & 7) * 256 + (blk >> 2) * 64, dk0 = (blk & 3) * 64;
        v4u v[8];
#pragma unroll
        for (int i = 0; i < 8; ++i) v[i] = *(const GAS v4u*)(K2 + ((size_t)z * SEQ + s0 + rr + 8 * i) * RQK + dk0 + 8 * q);
#pragma unroll
        for (int i = 0; i < 8; ++i) { const int sl = rr + 8 * i; const unsigned w4[4] = {v[i].x, v[i].y, v[i].z, v[i].w};
#pragma unroll
            for (int e = 0; e < 8; ++e) T[(8 * q + e) * LDT + sl] = (bf16)((e & 1) ? (w4[e >> 1] >> 16) : (w4[e >> 1] & 0xffffu)); }
        LDS_WAIT(); asm volatile("" ::: "memory");
        const float lf = lg2[2 * h], lb = lg2[2 * h + 1];
        float ff[8], fb[8];
#pragma unroll
        for (int e = 0; e < 8; ++e) { const int j = (s0 + 8 * q + e) & 255; ff[e] = __builtin_amdgcn_exp2f(lf * (float)(256 - j)); fb[e] = __builtin_amdgcn_exp2f(lb * (float)j); }
#pragma unroll
        for (int jj = 0; jj < 8; ++jj) { const int dk = rr + 8 * jj; const v4u t = *(const LAS v4u*)(T + dk * LDT + 8 * q);
            const float x[8] = {pg8::bf_lo(t.x), pg8::bf_hi(t.x), pg8::bf_lo(t.y), pg8::bf_hi(t.y), pg8::bf_lo(t.z), pg8::bf_hi(t.z), pg8::bf_lo(t.w), pg8::bf_hi(t.w)};
            v4u of, ob;
            of.x = pk2(x[0] * ff[0], x[1] * ff[1]); of.y = pk2(x[2] * ff[2], x[3] * ff[3]); of.z = pk2(x[4] * ff[4], x[5] * ff[5]); of.w = pk2(x[6] * ff[6], x[7] * ff[7]);
            ob.x = pk2(x[0] * fb[0], x[1] * fb[1]); ob.y = pk2(x[2] * fb[2], x[3] * fb[3]); ob.z = pk2(x[4] * fb[4], x[5] * fb[5]); ob.w = pk2(x[6] * fb[6], x[7] * fb[7]);
            bf16* d = KT + ((size_t)(z * 2) * RQK + dk0 + dk) * SEQ + s0 + 8 * q;
            *(GAS v4u*)d = of; *(GAS v4u*)(d + (size_t)RQK * SEQ) = ob; }
        LDS_WAIT(); asm volatile("" ::: "memory");
    }
    __syncthreads();
}
struct ChainOrder {
    static constexpr bool GATHER = false, CARRY = true;
    const char* A; const char* B; const float* lg2; int G, c;
    __device__ __forceinline__ bool next(int i, pg8::Unit& u) const {
        const int ch = c + (i / 7) * G; if (ch >= 256) return false; const int st = i % 7, dir = (ch >> 1) & 1;
        u.z = ch >> 2; u.aux = ch & 3; u.pn = dir ? 7 - st : st; u.pm = dir ? 6 - st : st + 1; return true;
    }
    __device__ __forceinline__ const char* abase(const pg8::Unit& u) const { return A + ((size_t)(u.z * 8 + u.pn) * RV + (u.aux & 1) * 256) * 256 * 2; }
    __device__ __forceinline__ const char* bbase(const pg8::Unit& u) const { return B + (((size_t)(u.z * 2 + (u.aux >> 1)) * RQK) * SEQ + u.pn * 256) * 2; }
    __device__ __forceinline__ unsigned arow(const pg8::Unit&, int r) const { return (unsigned)r; }
    __device__ __forceinline__ float carry(const pg8::Unit& cur, const pg8::Unit& nxt, int) const {
        return (cur.z == nxt.z && cur.aux == nxt.aux) ? __builtin_amdgcn_exp2f(lg2[2 * (cur.z & 7) + (cur.aux >> 1)] * 256.0f) : 0.0f; }
    __device__ __forceinline__ void a_ready(const pg8::Unit&) const {}
    __device__ __forceinline__ void done(const pg8::Unit&) const {}
};
struct EpiState {
    static constexpr bool PERM = true;
    unsigned short* ST;
    __device__ __forceinline__ void operator()(const pg8::f32x4 (&acc)[2][2][4][2], const pg8::Unit& u, int wr, int wc, int fr, int fq) const {
        using namespace pg8;
        unsigned short* base = ST + ((size_t)((u.z * 8 + u.pm) * 2 + (u.aux >> 1)) * RV + (u.aux & 1) * 256 + wr * 64 + fr) * 256 + wc * 32 + 8 * fq;
#pragma unroll
        for (int ai = 0; ai < 2; ++ai)
#pragma unroll
            for (int m = 0; m < 4; ++m) { unsigned short* rowp = base + (size_t)(ai * HALF + m * 16) * 256;
#pragma unroll
                for (int bj = 0; bj < 2; ++bj) { const f32x4 v0 = acc[ai][bj][m][0], v1 = acc[ai][bj][m][1];
                    u32x4 w; w.x = cvt_pk_bf16(v0[0], v0[1]); w.y = cvt_pk_bf16(v0[2], v0[3]); w.z = cvt_pk_bf16(v1[0], v1[1]); w.w = cvt_pk_bf16(v1[2], v1[3]);
                    *(GAS u32x4*)(rowp + bj * HALF) = w; } }
    }
};
__device__ __forceinline__ void chain_zero(Frame& F, bf16* ST) {
    for (int ch = F.vcu; ch < 256; ch += F.G) { const int z = ch >> 2, dir = (ch >> 1) & 1, dvh = ch & 1;
        bf16* base = ST + ((size_t)((z * 8 + (dir ? 7 : 0)) * 2 + dir) * RV + dvh * 256) * 256;
        for (int k = F.tid; k < 256 * 32; k += NWAVES * 64) *(GAS v4u*)(base + (size_t)k * 8) = (v4u){0u, 0u, 0u, 0u}; }
}
struct YOrder {
    static constexpr bool GATHER = false, CARRY = true;
    const char* Q; const char* PD; const char* VTC; const char* ST; const char* Z0; const float* lg2; int G, c;
    __device__ __forceinline__ bool next(int i, pg8::Unit& u) const { const int L = (i / 3) * G + c; if (L >= 1024) return false; const int zc = L >> 1; u.z = zc >> 3; u.pm = zc & 7; u.pn = L & 1; u.aux = i % 3; return true; }
    __device__ __forceinline__ const char* abase(const pg8::Unit& u) const { return (u.aux == 0 ? PD : Q) + (size_t)(u.z * 8 + u.pm) * 256 * 256 * 2; }
    __device__ __forceinline__ const char* bbase(const pg8::Unit& u) const {
        if ((u.aux == 2 && u.pm == 0) || (u.aux == 1 && u.pm == 7)) return Z0;
        return u.aux == 0 ? VTC + ((size_t)(u.z * 8 + u.pm) * RV + u.pn * 256) * 256 * 2 : ST + ((size_t)((u.z * 8 + u.pm) * 2 + (u.aux == 1 ? 1 : 0)) * RV + u.pn * 256) * 256 * 2; }
    __device__ __forceinline__ unsigned arow(const pg8::Unit&, int r) const { return (unsigned)r; }
    __device__ __forceinline__ float carry(const pg8::Unit& cur, const pg8::Unit&, int row) const {
        const int h = cur.z & 7;
        const float lf = lg2[2 * h], lb = lg2[2 * h + 1], d = (float)(256 - row);
        return cur.aux == 0 ? __builtin_amdgcn_exp2f(-lb * d) : (cur.aux == 1 ? __builtin_amdgcn_exp2f(lb * d - lf * (float)row) : 0.0f); }
    __device__ __forceinline__ void a_ready(const pg8::Unit&) const {}
    __device__ __forceinline__ void done(const pg8::Unit&) const {}
};
struct EpiYOut {
    static constexpr bool PERM = true;
    unsigned short* Y; float* gpart; const float* lg2;
    __device__ __forceinline__ void operator()(const pg8::f32x4 (&acc)[2][2][4][2], const pg8::Unit& u, int wr, int wc, int fr, int fq) const {
        using namespace pg8;
        if (u.aux != 2) return;
        const int b = u.z >> 3, h = u.z & 7; const float lf = lg2[2 * h];
        unsigned short* base = Y + ((size_t)b * SEQ + u.pm * 256 + wr * 64 + fr) * RVW + h * RV + u.pn * 256 + wc * 32 + 8 * fq;
        float sq[2][4];
#pragma unroll
        for (int ai = 0; ai < 2; ++ai)
#pragma unroll
            for (int m = 0; m < 4; ++m) { unsigned short* rowp = base + (size_t)(ai * HALF + m * 16) * RVW; float t2 = 0.f; const float cf = __builtin_amdgcn_exp2f(lf * (float)(ai * HALF + wr * 64 + m * 16 + fr));
#pragma unroll
                for (int bj = 0; bj < 2; ++bj) { const f32x4 v0 = acc[ai][bj][m][0] * cf, v1 = acc[ai][bj][m][1] * cf;
                    u32x4 w; w.x = cvt_pk_bf16(v0[0], v0[1]); w.y = cvt_pk_bf16(v0[2], v0[3]); w.z = cvt_pk_bf16(v1[0], v1[1]); w.w = cvt_pk_bf16(v1[2], v1[3]);
                    *(GAS u32x4*)(rowp + bj * HALF) = w;
                    const float q0 = bf_lo(w.x), q1 = bf_hi(w.x), q2 = bf_lo(w.y), q3 = bf_hi(w.y), q4 = bf_lo(w.z), q5 = bf_hi(w.z), q6 = bf_lo(w.w), q7 = bf_hi(w.w);
                    t2 += ((q0 * q0 + q1 * q1) + (q2 * q2 + q3 * q3)) + ((q4 * q4 + q5 * q5) + (q6 * q6 + q7 * q7)); }
                t2 += __shfl_xor(t2, 16); t2 += __shfl_xor(t2, 32); sq[ai][m] = t2; }
#pragma unroll
        for (int ai = 0; ai < 2; ++ai) {
            const float v2 = fq == 0 ? sq[ai][0] : (fq == 1 ? sq[ai][1] : (fq == 2 ? sq[ai][2] : sq[ai][3]));
            const int tok = b * SEQ + u.pm * 256 + ai * HALF + wr * 64 + 16 * fq + fr;
            gpart[(size_t)(u.pn * 4 + wc) * (M * RH) + (size_t)tok * RH + h] = v2;
        }
    }
};
constexpr float Z_SCALE = 8.0f;
struct EpiGateNorm {
    static constexpr bool PERM = true;
    unsigned char* Z; const unsigned short* Y; const float* gpart; const float* sx; float sw;
    __device__ __forceinline__ void operator()(const pg8::f32x4 (&acc)[2][2][4][2], const pg8::Unit& u, int wr, int wc, int fr, int fq) const {
        using namespace pg8;
        const int h = u.pn >> 1, row0 = u.pm * BM + wr * 64 + fr, col0 = u.pn * BM + wc * 32 + 8 * fq;
        float s2[2][4];
#pragma unroll
        for (int ai = 0; ai < 2; ++ai)
#pragma unroll
            for (int m = 0; m < 4; ++m) { const float* gp = gpart + (size_t)(row0 + ai * HALF + m * 16) * RH + h;
                s2[ai][m] = gp[(size_t)(2 * fq) * (M * RH)] + gp[(size_t)(2 * fq + 1) * (M * RH)]; }
        float rn[2][4];
#pragma unroll
        for (int ai = 0; ai < 2; ++ai)
#pragma unroll
            for (int m = 0; m < 4; ++m) { float t = s2[ai][m]; t += __shfl_xor(t, 16); t += __shfl_xor(t, 32); rn[ai][m] = rsqrtf(t * (1.f / RV) + GN_EPS); }
        float rsx[2][4];
#pragma unroll
        for (int ai = 0; ai < 2; ++ai)
#pragma unroll
            for (int m = 0; m < 4; ++m) rsx[ai][m] = sx[row0 + ai * HALF + m * 16] * sw;
#pragma unroll
        for (int ai = 0; ai < 2; ++ai) {
            u32x4 yw[4][2];
#pragma unroll
            for (int m = 0; m < 4; ++m)
#pragma unroll
                for (int bj = 0; bj < 2; ++bj) yw[m][bj] = __builtin_nontemporal_load((const GAS u32x4*)(Y + (size_t)(row0 + ai * HALF + m * 16) * RVW + col0 + bj * HALF));
#pragma unroll
            for (int m = 0; m < 4; ++m) { const float r1 = rn[ai][m] * Z_SCALE; const size_t off = (size_t)(row0 + ai * HALF + m * 16) * RVW + col0;
#pragma unroll
                for (int bj = 0; bj < 2; ++bj) { const u32x4 y4 = yw[m][bj]; const f32x4 v0 = i2f4(acc[ai][bj][m][0]) * rsx[ai][m], v1 = i2f4(acc[ai][bj][m][1]) * rsx[ai][m];
                    u32x2 w; w.x = pk4_fp8(silu_f(v0[0]) * bf_lo(y4.x) * r1, silu_f(v0[1]) * bf_hi(y4.x) * r1, silu_f(v0[2]) * bf_lo(y4.y) * r1, silu_f(v0[3]) * bf_hi(y4.y) * r1);
                    w.y = pk4_fp8(silu_f(v1[0]) * bf_lo(y4.z) * r1, silu_f(v1[1]) * bf_hi(y4.z) * r1, silu_f(v1[2]) * bf_lo(y4.w) * r1, silu_f(v1[3]) * bf_hi(y4.w) * r1);
                    *(GAS u32x2*)(Z + off + bj * HALF) = w; } }
        }
    }
};
struct Args { const float* in[17]; float* out; unsigned char* ws; int ph_lo, ph_hi; };
__global__ void __launch_bounds__(NWAVES * 64, 2) fwd(Args args) {
    extern __shared__ __attribute__((aligned(16))) unsigned char lds[];
    Frame F;
    F.lds = (LAS unsigned char*)lds;
    F.MISC = (volatile LAS unsigned*)(F.lds + MISC_OFF);
    F.tid = threadIdx.x; F.lane = F.tid & 63; F.wave = __builtin_amdgcn_readfirstlane(F.tid >> 6);
    F.G = gridDim.x; { const int bx = blockIdx.x; F.vcu = (F.G % 8 == 0) ? (bx % 8) * (F.G / 8) + bx / 8 : bx; }
    F.ws = args.ws;
    unsigned char* ws = args.ws;
    F.ctl = (gu32*)(ws + WS_CTL);
    Ins I;
    I.x = args.in[0]; I.awin = args.in[1]; I.awout = args.in[2]; I.rpb = args.in[3]; I.rwin = args.in[4]; I.rwout = args.in[5]; I.dfw = args.in[6]; I.dbw = args.in[7];
    I.wgr = args.in[8]; I.bgr = args.in[9]; I.wer = args.in[10]; I.ber = args.in[11]; I.wgate = args.in[12]; I.wup = args.in[13]; I.wdown = args.in[14]; I.lng = args.in[15]; I.lnb = args.in[16];
    for (int u = F.tid; u < (LDS_BYTES - LDSCTL_OFF) / 4; u += NWAVES * 64) ((LAS unsigned*)(F.lds + LDSCTL_OFF))[u] = 0u;
    __syncthreads();
    XcdBarrier bar = xcd_barrier_post((unsigned*)(F.ctl + CW_BAR), F.MISC + 8);
    const int lo = args.ph_lo, hi = args.ph_hi;
#define IN(k) (lo <= (k) && (k) < hi)
#define BOTH(k) (IN(k) && IN((k) + 1))
#define GRID_BAR() xcd_barrier(bar)
#define REPS(k) (((REPEAT_MASK >> (k)) & 1u) ? 2 : 1)
    unsigned char* XF8 = ws + WS_A0; unsigned char* O8 = ws + WS_A0 + 32 * MiB; unsigned char* QB = ws + WS_A1; unsigned char* VT = ws + WS_A3;
    unsigned char* WAIN = ws + WS_WAIN;
#define FSC_INV1(IDX) __uint_as_float((unsigned)(127 - ((const GAS int*)F.ctl)[CW_FSC + (IDX)]) << 23)

    if (IN(0)) { for (int rep = 0; rep < REPS(0); ++rep) p0_prologue(I, F); if (BOTH(0)) GRID_BAR(); }

    if (IN(1)) {
        if (F.vcu & 1) conv_rest(I, F);
        for (int rep = 0; rep < REPS(1); ++rep) {
        { pg8::Gemm g{D / 2, D / 2, D / 2}; typedef pg8::DenseOrderT<M / 256, 4096 / 256, 1, 1> DO_; DO_ S; S.init(XF8, WAIN, D / 2, D / 2, 0, 0, F.G, (int)blockIdx.x);
          EpiF8 E{QB, D, D, (size_t)(WS_A2 - WS_A1), FSC_INV1(4), FSC_INV1(4)};
          pg8::gemm_phase<EpiF8, DO_, true>(F.lds + RING_OFF, g, S, E); }
        { pg8::Gemm g{D / 2, D / 2, D / 2}; typedef pg8::DenseOrderT<D / 256, M / 256, 1, 1> DO_; DO_ S; S.init(WAIN + (size_t)4096 * D, XF8, D / 2, D / 2, 0, 0, F.G, (int)blockIdx.x);
          EpiF8 E{VT, SEQ, SEQ, (size_t)D * SEQ, FSC_INV1(4) * natt::ATT_V_SCALE, FSC_INV1(4) * natt::ATT_V_SCALE};
          pg8::gemm_phase<EpiF8, DO_, true>(F.lds + RING_OFF, g, S, E); } }
        if (!(F.vcu & 1)) conv_rest(I, F);
        if (BOTH(1)) GRID_BAR();
    }
    if (IN(2)) {
        if (F.vcu & 1) conv_l0(I, F, MOE_ITEMS / 2, MOE_ITEMS);
        for (int rep = 0; rep < REPS(2); ++rep) natt::attn_phase(F.lds + RING_OFF, QB, ws + WS_A2, VT, O8, I.rpb, F.G, F.vcu);
        if (!(F.vcu & 1)) { __syncthreads(); conv_l0(I, F, MOE_ITEMS / 2, MOE_ITEMS); }
        if (BOTH(2)) GRID_BAR();
    }
    if (IN(3)) { if (F.vcu & 1) conv_ret(I, F);
        for (int rep = 0; rep < REPS(3); ++rep) {
        pg8::Gemm g{D / 2, D / 2, D / 2}; typedef pg8::DenseOrderT<M / 256, D / 256, 1, 1> DO_; DO_ S; S.init(O8, ws + WS_WAOUT, D / 2, D / 2, 0, 0, F.G, (int)blockIdx.x);
        EpiResStats<false> E{(const void*)I.x, (bf16*)(ws + WS_A4), (float*)(ws + WS_PART), FSC_INV1(5) * (1.0f / natt::ATT_O_SCALE)};
        pg8::gemm_phase<EpiResStats<false>, DO_, true>(F.lds + RING_OFF, g, S, E); }
        if (!(F.vcu & 1)) conv_ret(I, F);
        if (BOTH(3)) GRID_BAR();
    }
    unsigned* cnt0 = (unsigned*)(ws + WS_CTL) + CW_CNT; int* list = (int*)(ws + WS_LIST); float* routew = (float*)(ws + WS_ROUTEW);
    LAS int* mtab = (LAS int*)(F.lds + LDSCTL_OFF + 1024);
    if (IN(4)) {
        for (int rep = 0; rep < REPS(4); ++rep) ln_router_phase(F, (const bf16*)(ws + WS_A4), (const float*)(ws + WS_PART), I.lng, I.lnb, (bf16*)(ws + WS_A1), ws + WS_A2, ws + WS_WRF, I.bgr, I.ber, cnt0, list, routew, rep == 0);
        if (BOTH(4)) GRID_BAR();
    }
#define FSC_INV(LY, KIND) __uint_as_float((unsigned)(127 - ((const GAS int*)F.ctl)[CW_FSC + (LY) * 2 + (KIND)]) << 23)
#define MOE_LAYER(CNT, XSRC, HBUF, OBUF, PH, LY)                                                                                                                                        \
    if (IN(PH)) {                                                                                                                                                                     \
        moe_build_table(F, mtab, CNT);                                                                                                                                                \
        const int T_ = mtab[32], U1_ = 4 * T_, Xn_ = (U1_ / F.G) * F.G;                                                                                                               \
        for (int rep = 0; rep < REPS(PH); ++rep) {                                                                                                                                    \
        pg8::Gemm g{D / 2, D / 2, D / 2}; MoeOrder<true> S{mtab, CNT, list, (const char*)(XSRC), (const char*)(ws + WS_WM1), 0, (size_t)1024 * D, (size_t)256 * D, 4, F.G, F.vcu, 0, Xn_, 0, 0}; \
        EpiSwiGLU E{(unsigned char*)(HBUF), FSC_INV(LY, 0)};                                                                                                                                                   \
        pg8::gemm_phase<EpiSwiGLU, MoeOrder<true>, true>(F.lds + RING_OFF, g, S, E); }                                                                                                \
        if (BOTH(PH)) GRID_BAR();                                                                                                                                                     \
    }                                                                                                                                                                                 \
    if (IN(PH + 1)) {                                                                                                                                                                 \
        moe_build_table(F, mtab, CNT);                                                                                                                                                \
        const int T_ = mtab[32], U1_ = 4 * T_, Xn_ = (U1_ / F.G) * F.G, nleft_ = U1_ - Xn_, U2y_ = 8 * (Xn_ / 4), U2_ = 8 * T_;                                                       \
        for (int rep = 0; rep < REPS(PH + 1); ++rep) {                                                                                                                                \
        { pg8::Gemm g{D / 2, D / 2, D / 2}; MoeOrder<true> S{mtab, CNT, list, (const char*)(XSRC), (const char*)(ws + WS_WM1), 0, (size_t)1024 * D, (size_t)256 * D, 4, F.G, F.vcu, Xn_, U1_, 0, 0}; \
          EpiSwiGLU E{(unsigned char*)(HBUF), FSC_INV(LY, 0)};                                                                                                                                                 \
          pg8::gemm_phase<EpiSwiGLU, MoeOrder<true>, true>(F.lds + RING_OFF, g, S, E); }                                                                                              \
        { pg8::Gemm g{FF / 2, FF / 2, FF / 2}; MoeOrder<false> S{mtab, CNT, list, (const char*)(HBUF), (const char*)(ws + WS_WM2), (size_t)256 * FF, (size_t)D * FF, (size_t)256 * FF, 8, F.G, F.vcu, 0, U2y_, nleft_, 2}; \
          EpiScatter E{CNT, list, (unsigned char*)(OBUF), FSC_INV(LY, 1) * O_SCALE};                                                                                                                                     \
          pg8::gemm_phase<EpiScatter, MoeOrder<false>, true>(F.lds + RING_OFF, g, S, E); }                                                                                            \
        GRID_BAR();                                                                                                                                                                   \
        { pg8::Gemm g{FF / 2, FF / 2, FF / 2}; MoeOrder<false> S{mtab, CNT, list, (const char*)(HBUF), (const char*)(ws + WS_WM2), (size_t)256 * FF, (size_t)D * FF, (size_t)256 * FF, 8, F.G, F.vcu, U2y_, U2_, 0, 0}; \
          EpiScatter E{CNT, list, (unsigned char*)(OBUF), FSC_INV(LY, 1) * O_SCALE};                                                                                                                                     \
          pg8::gemm_phase<EpiScatter, MoeOrder<false>, true>(F.lds + RING_OFF, g, S, E); } }                                                                                          \
        if (BOTH(PH + 1)) GRID_BAR();                                                                                                                                                 \
    }
    MOE_LAYER(cnt0, ws + WS_A2, ws + WS_A6, ws + WS_A5, 5, 0)
    if (IN(7)) {
        for (int rep = 0; rep < REPS(7); ++rep) combine_ln_phase<false>(F, (const bf16*)(ws + WS_A4), (const float*)(ws + WS_PART), I.lng, I.lnb, (const unsigned char*)(ws + WS_A5), routew, I.lng + D, I.lnb + D, (bf16*)(ws + WS_A0), nullptr, ws + WS_X2I8, (float*)(ws + WS_SX));
        if (BOTH(7)) GRID_BAR();
    }
    bf16* X2 = (bf16*)(ws + WS_A0); bf16* Q2 = (bf16*)(ws + WS_Q2); bf16* K2 = (bf16*)(ws + WS_K2); bf16* PD = (bf16*)(ws + WS_PD); bf16* VTC = (bf16*)(ws + WS_VTC); bf16* STB = (bf16*)(ws + WS_ST); bf16* KTB = (bf16*)(ws + WS_KT);
    bf16* GZ = (bf16*)(ws + WS_A5); bf16* YR = (bf16*)(ws + WS_A6); unsigned char* WRIN = ws + WS_WRIN;
    const unsigned char* X2I8 = ws + WS_X2I8; const float* SX = (const float*)(ws + WS_SX);
#define RW_SC(PART) (((const GAS float*)F.ctl)[CW_FSC + 8 + (PART)] * (1.f / 127.f))
    const float* lg2t = (const float*)(ws + WS_DECAY);
    if (IN(8)) { for (int rep = 0; rep < REPS(8); ++rep) {
        int p0_, pstep_, npairs_;
        if (F.G == 256) {
            pg8::Gemm g{D / 2, D / 2, D / 2}; typedef pg8::DenseOrderT<M / 256, 4096 / 256, 1, 2> DQ_; DQ_ S; S.init(X2I8, WRIN, D / 2, D / 2, 0, 0, F.G, (int)blockIdx.x);
            EpiRetProj2 E{Q2, K2, (const float*)(ws + WS_TAB), (const float*)(ws + WS_TAB) + 2048 * 128, (const float*)(ws + WS_ROTD), SX, RW_SC(0)};
            pg8::gemm_phase<EpiRetProj2, DQ_, true>(F.lds + RING_OFF, g, S, E);
            pg8::Unit u0; S.next(0, u0); p0_ = u0.pm * 8 + u0.pn; pstep_ = 4; npairs_ = 2;
        } else {
            pg8::Gemm g{D / 2, D / 2, D / 2}; PairOrder S{(const char*)X2I8, (const char*)WRIN, F.G, F.vcu};
            EpiRetProj2 E{Q2, K2, (const float*)(ws + WS_TAB), (const float*)(ws + WS_TAB) + 2048 * 128, (const float*)(ws + WS_ROTD), SX, RW_SC(0)};
            pg8::gemm_phase<EpiRetProj2, PairOrder, true>(F.lds + RING_OFF, g, S, E);
            p0_ = F.vcu; pstep_ = F.G; npairs_ = (512 - F.vcu + F.G - 1) / F.G; }
        { pg8::Gemm g{RQK, RQK, RQK}; DiagOrder S{(const char*)Q2, (const char*)K2, p0_, pstep_, npairs_};
          EpiDiag E{PD, lg2t};
          pg8::gemm_phase<EpiDiag, DiagOrder, true>(F.lds + RING_OFF, g, S, E); }
        kt_phase(F, K2, KTB, lg2t, p0_, pstep_, npairs_);
        { pg8::Gemm g{D / 2, D / 2, D / 2}; typedef pg8::DenseOrderT<RVW / 256, M / 256, 1, 2> DO_; DO_ S; S.init(WRIN + (size_t)8192 * D, X2I8, D / 2, D / 2, 0, 0, F.G, (int)blockIdx.x);
          EpiVtCat E{VTC, SX, RW_SC(1)};
          pg8::gemm_phase<EpiVtCat, DO_, true>(F.lds + RING_OFF, g, S, E); } }
        if (BOTH(8)) GRID_BAR();
    }
    if (IN(10)) { for (int rep = 0; rep < REPS(10); ++rep) {
        pg8::Gemm g{256, SEQ, 256}; ChainOrder S{(const char*)VTC, (const char*)KTB, lg2t, F.G, F.vcu};
        EpiState E{STB};
        pg8::gemm_phase<EpiState, ChainOrder, true>(F.lds + RING_OFF, g, S, E); }
        if (BOTH(10)) GRID_BAR();
    }
    if (IN(11)) { for (int rep = 0; rep < REPS(11); ++rep) {
        pg8::Gemm g{256, 256, 256}; YOrder S{(const char*)Q2, (const char*)PD, (const char*)VTC, (const char*)STB, (const char*)(ws + WS_CTL + MiB), lg2t, F.G, F.vcu};
        EpiYOut E{YR, (float*)(ws + WS_PART), lg2t};
        pg8::gemm_phase<EpiYOut, YOrder, true>(F.lds + RING_OFF, g, S, E); }
        if (BOTH(11)) GRID_BAR();
    }
    if (IN(12)) { if (F.vcu & 1) conv_l1(I, F, 0, MOE_ITEMS / 2);
        for (int rep = 0; rep < REPS(12); ++rep) {
        pg8::Gemm g{D / 2, D / 2, D / 2}; typedef pg8::DenseOrderT<M / 256, RVW / 256, 1, 2> DO_; DO_ S; S.init(X2I8, WRIN + (size_t)4096 * D, D / 2, D / 2, 0, 0, F.G, (int)blockIdx.x);
        EpiGateNorm E{(unsigned char*)GZ, YR, (const float*)(ws + WS_PART), SX, RW_SC(2)};
        pg8::gemm_phase<EpiGateNorm, DO_, true>(F.lds + RING_OFF, g, S, E); }
        if (!(F.vcu & 1)) conv_l1(I, F, 0, MOE_ITEMS / 2);
        if (BOTH(12)) GRID_BAR();
    }
    if (IN(18)) {
        if (F.vcu & 1) conv_l1(I, F, MOE_ITEMS / 2, MOE_ITEMS);
        for (int rep = 0; rep < REPS(18); ++rep) {
        pg8::Gemm g{RVW / 2, RVW / 2, RVW / 2}; typedef pg8::DenseOrderT<M / 256, D / 256, 1, 1> DO_; DO_ S; S.init(GZ, ws + WS_WROUT, RVW / 2, RVW / 2, 0, 0, F.G, (int)blockIdx.x);
        EpiResStats<true> E{(const void*)X2, (bf16*)(ws + WS_A1), (float*)(ws + WS_PART), FSC_INV1(6) * (1.0f / Z_SCALE)};
        pg8::gemm_phase<EpiResStats<true>, DO_, true>(F.lds + RING_OFF, g, S, E); }
        if (!(F.vcu & 1)) conv_l1(I, F, MOE_ITEMS / 2, MOE_ITEMS);
        if (BOTH(18)) GRID_BAR();
    }
    unsigned* cnt1 = cnt0 + 2048;
    if (IN(19)) {
        for (int rep = 0; rep < REPS(19); ++rep) ln_router_phase(F, (const bf16*)(ws + WS_A1), (const float*)(ws + WS_PART), I.lng + 2 * D, I.lnb + 2 * D, (bf16*)(ws + WS_A2), ws + WS_A5, ws + WS_WRF + WRF_LAYER_BYTES, I.bgr + 4, I.ber + 32, cnt1, list, routew, rep == 0);
        if (BOTH(19)) GRID_BAR();
    }
    MOE_LAYER(cnt1, ws + WS_A5, ws + WS_A6, ws + WS_A3, 20, 1)
#undef MOE_LAYER
#undef FSC_INV
    if (IN(22)) {
        for (int rep = 0; rep < REPS(22); ++rep) combine_ln_phase<true>(F, (const bf16*)(ws + WS_A1), (const float*)(ws + WS_PART), I.lng + 2 * D, I.lnb + 2 * D, (const unsigned char*)(ws + WS_A3), routew, I.lng + 3 * D, I.lnb + 3 * D, nullptr, args.out);
    }
#undef IN
#undef BOTH
#undef GRID_BAR
}
#if DEBUG_STAGE != 0
namespace dbg {
__global__ __launch_bounds__(256) void cmp(const void* fast, int is_bf16, long fs_r, long fs_c, float fscale, const float* naive, long ns_r, long ns_c, int R, int C, float* acc2) {
    float e = 0.f, r = 0.f;
    for (long idx = (long)blockIdx.x * 256 + threadIdx.x; idx < (long)R * C; idx += (long)gridDim.x * 256) {
        const long i = idx / C, j = idx % C;
        float f; if (is_bf16) f = __uint_as_float(((unsigned)((const unsigned short*)fast)[i * fs_r + j * fs_c]) << 16); else f = ((const float*)fast)[i * fs_r + j * fs_c];
        const float n = naive[i * ns_r + j * ns_c]; const float d = f * fscale - n; e += d * d; r += n * n;
    }
#pragma unroll
    for (int o = 32; o >= 1; o >>= 1) { e += __shfl_xor(e, o); r += __shfl_xor(r, o); }
    if ((threadIdx.x & 63) == 0) { atomicAdd(acc2, e); atomicAdd(acc2 + 1, r); }
}
__global__ __launch_bounds__(256) void perturb(float* out, size_t n, const float* acc, int nchk) {
    float s = 0.f; for (int k = 0; k < nchk; ++k) s += acc[2 * k] / acc[2 * k + 1];
    const float f = 1.f + sqrtf(s);
    for (size_t i = (size_t)blockIdx.x * 256 + threadIdx.x; i < n; i += (size_t)gridDim.x * 256) out[i] *= f;
}
__global__ __launch_bounds__(256) void copy2d16(unsigned short* dst, long dp, const unsigned short* src, long sp, int R, int C) {
    for (long idx = (long)blockIdx.x * 256 + threadIdx.x; idx < (long)R * C; idx += (long)gridDim.x * 256) { const long i = idx / C, j = idx % C; dst[i * dp + j] = src[i * sp + j]; }
}
__global__ __launch_bounds__(256) void axpy(float* y, const float* x, float a, long n) { for (long i = (long)blockIdx.x * 256 + threadIdx.x; i < n; i += (long)gridDim.x * 256) y[i] += a * x[i]; }
}
#endif

#ifndef DBG_NCHK
#define DBG_NCHK 2
#endif
#ifndef DEBUG_STAGE
#define DEBUG_STAGE 0
#endif
extern "C" void kernel_launch(void* const* d_in, const int* in_sizes, int n_in, void* d_out, int out_size, void* d_ws, size_t ws_size, hipStream_t stream) {
    static int grid = 0;
    if (grid == 0) {
        if (n_in != 17 || in_sizes[0] != M * D || out_size != M * D || ws_size < (DEBUG_STAGE ? WS_END : WS_FAST_END)) { fprintf(stderr, "kernel_launch: unexpected shapes (n_in %d, ws %zu)\n", n_in, ws_size); grid = -1; return; }
        int dev = 0, cus = 0, per_cu = 0;
        if (hipGetDevice(&dev) != hipSuccess || hipDeviceGetAttribute(&cus, hipDeviceAttributeMultiprocessorCount, dev) != hipSuccess) { grid = -1; return; }
        if (hipFuncSetAttribute((const void*)fwd, hipFuncAttributeMaxDynamicSharedMemorySize, LDS_BYTES) != hipSuccess) { fprintf(stderr, "kernel_launch: hipFuncSetAttribute failed\n"); grid = -1; return; }
        if (hipOccupancyMaxActiveBlocksPerMultiprocessor(&per_cu, (const void*)fwd, NWAVES * 64, LDS_BYTES) != hipSuccess || per_cu < 1) { fprintf(stderr, "kernel_launch: occupancy query says %d\n", per_cu); (void)hipGetLastError(); grid = -1; return; }
        grid = cus;
    }
    if (grid < 0) return;
    unsigned char* ws = (unsigned char*)d_ws;
    if (hipMemsetAsync(ws + WS_CTL, 0, CTL_ZERO_BYTES, stream) != hipSuccess) return;
    Args a{};
    for (int i = 0; i < 17; ++i) a.in[i] = (const float*)d_in[i];
    a.out = (float*)d_out; a.ws = ws;
#if DEBUG_STAGE == 0
    a.ph_lo = 0; a.ph_hi = 64;
    hipLaunchKernelGGL(fwd, dim3(grid), dim3(NWAVES * 64), LDS_BYTES, stream, a);
#else
    nv::In NI; NI.x = a.in[0]; NI.awin = a.in[1]; NI.awout = a.in[2]; NI.rpb = a.in[3]; NI.rwin = a.in[4]; NI.rwout = a.in[5]; NI.dfw = a.in[6]; NI.dbw = a.in[7];
    NI.wgr = a.in[8]; NI.bgr = a.in[9]; NI.wer = a.in[10]; NI.ber = a.in[11]; NI.wgate = a.in[12]; NI.wup = a.in[13]; NI.wdown = a.in[14]; NI.lng = a.in[15]; NI.lnb = a.in[16];
    float* acc = (float*)(ws + WS_CTL) + CW_DBG; float* dbg1 = (float*)(ws + WS_DBG1); unsigned char* dbg2 = ws + WS_DBG2; float* nscr = (float*)(ws + WS_A0);
    int nchk = 0;
#if DEBUG_STAGE == 1
    a.ph_lo = 0; a.ph_hi = 2;
    hipLaunchKernelGGL(fwd, dim3(grid), dim3(NWAVES * 64), LDS_BYTES, stream, a);
    (void)hipMemcpyAsync(dbg2, ws + WS_A1, (size_t)2048 * 2048 * 2, hipMemcpyDeviceToDevice, stream);
    (void)hipMemcpyAsync(dbg2 + 8 * MiB, ws + WS_A2, (size_t)2048 * 2048 * 2, hipMemcpyDeviceToDevice, stream);
    hipLaunchKernelGGL(dbg::copy2d16, dim3(1024), dim3(256), 0, stream, (unsigned short*)(dbg2 + 16 * MiB), 2048L, (const unsigned short*)(ws + WS_A3), (long)M, 2048, 2048);
    nv::forward(NI, (float*)d_out, nscr, stream, 1u << 0, dbg1);
    hipLaunchKernelGGL(dbg::cmp, dim3(1024), dim3(256), 0, stream, (const void*)dbg2, 1, 2048L, 1L, 1.f / 0.08838834764831845f, (const float*)dbg1, 6144L, 1L, 2048, 2048, acc + 0);
    hipLaunchKernelGGL(dbg::cmp, dim3(1024), dim3(256), 0, stream, (const void*)(dbg2 + 8 * MiB), 1, 2048L, 1L, 1.f, (const float*)dbg1 + 2048, 6144L, 1L, 2048, 2048, acc + 2);
    hipLaunchKernelGGL(dbg::cmp, dim3(1024), dim3(256), 0, stream, (const void*)(dbg2 + 16 * MiB), 1, 1L, 2048L, 1.f, (const float*)dbg1 + 4096, 6144L, 1L, 2048, 2048, acc + 4);
    nchk = 3;
#endif
#if DEBUG_STAGE == 3
    a.ph_lo = 0; a.ph_hi = 8;
    hipLaunchKernelGGL(fwd, dim3(grid), dim3(NWAVES * 64), LDS_BYTES, stream, a);
    (void)hipMemcpyAsync(dbg2, ws + WS_A0, (size_t)2048 * 2048 * 2, hipMemcpyDeviceToDevice, stream);
    (void)hipMemcpyAsync(dbg2 + 8 * MiB, ws + WS_A1, (size_t)2048 * 2048 * 2, hipMemcpyDeviceToDevice, stream);
    nv::forward(NI, (float*)d_out, nscr, stream, (1u << 3) | (1u << 4), dbg1);
    hipLaunchKernelGGL(dbg::cmp, dim3(1024), dim3(256), 0, stream, (const void*)dbg2, 1, 2048L, 1L, 1.f, (const float*)dbg1 + (8u << 20), 2048L, 1L, 2048, 2048, acc + 0);
    hipLaunchKernelGGL(dbg::cmp, dim3(1024), dim3(256), 0, stream, (const void*)(dbg2 + 8 * MiB), 1, 2048L, 1L, 1.f, (const float*)dbg1 + (12u << 20), 2048L, 1L, 2048, 2048, acc + 2);
    nchk = DBG_NCHK;
#endif
#if DEBUG_STAGE == 2
    a.ph_lo = 0; a.ph_hi = 4;
    hipLaunchKernelGGL(fwd, dim3(grid), dim3(NWAVES * 64), LDS_BYTES, stream, a);
    (void)hipMemcpyAsync(dbg2, ws + WS_A1, (size_t)2048 * 2048 * 2, hipMemcpyDeviceToDevice, stream);
    (void)hipMemcpyAsync(dbg2 + 8 * MiB, ws + WS_A4, (size_t)2048 * 2048 * 2, hipMemcpyDeviceToDevice, stream);
    nv::forward(NI, (float*)d_out, nscr, stream, (1u << 1) | (1u << 2), dbg1);
    hipLaunchKernelGGL(dbg::axpy, dim3(1024), dim3(256), 0, stream, dbg1 + (4u << 20), NI.x, nv::ALPHA, (long)2048 * 2048);
    hipLaunchKernelGGL(dbg::cmp, dim3(1024), dim3(256), 0, stream, (const void*)dbg2, 1, 2048L, 1L, 1.f, (const float*)dbg1, 2048L, 1L, 2048, 2048, acc + 0);
    hipLaunchKernelGGL(dbg::cmp, dim3(1024), dim3(256), 0, stream, (const void*)(dbg2 + 8 * MiB), 1, 2048L, 1L, 1.f, (const float*)dbg1 + (4u << 20), 2048L, 1L, 2048, 2048, acc + 2);
    nchk = DBG_NCHK;
#endif
    hipLaunchKernelGGL(dbg::perturb, dim3(2048), dim3(256), 0, stream, (float*)d_out, (size_t)M * D, (const float*)acc, nchk);
#endif
}
```
